# Optimizing an MI355X kernel written in HIP

```python
import jax
import jax.numpy as jnp
from jax import lax
import numpy as np

D_MODEL = 1024
BATCH = 8
SEQ = 4096
DEPTH = 1

GRID_W = 64
EPS = 1e-6
ATTN_HEADS = 8
ATTN_KV_HEADS = 2
ATTN_HEAD_DIM = 64
ATTN_WIDTH = ATTN_HEADS * ATTN_HEAD_DIM
KV_WIDTH = ATTN_KV_HEADS * ATTN_HEAD_DIM
Q_BLOCK = 128
ROPE_THETA = 10000.0
MLSTM_HEADS = 4
MLSTM_HEAD_DIM = 128
MLSTM_WIDTH = MLSTM_HEADS * MLSTM_HEAD_DIM
MLSTM_CHUNK = 64
CONV_WIDTH = 5
N_GATES = 4 * MLSTM_HEADS
FORGET_BIAS_LO = 3.0
FORGET_BIAS_HI = 6.0
MIX_WIDTH = ATTN_WIDTH + MLSTM_WIDTH
IN_PROJ_WIDTH = ATTN_WIDTH + 2 * KV_WIDTH + 4 * MLSTM_WIDTH + N_GATES
FFN_HIDDEN = 256 * ((8 * D_MODEL + 3 * 256 - 1) // (3 * 256))

kernel_name = 'hymba_axial_gqa_bi_mlstm_adaln_block'


def rms_norm(x, g):
    xf = x.astype(jnp.float32)
    y = xf * lax.rsqrt(jnp.mean(xf * xf, axis=-1, keepdims=True) + EPS)
    return (y * g.astype(jnp.float32)).astype(x.dtype)


def modulate(h, shift, scale):
    return h * (1.0 + scale[:, None, :]) + shift[:, None, :]


def axial_rope_tables(seq):
    rows = seq // GRID_W
    row = jnp.repeat(jnp.arange(rows, dtype=jnp.float32), GRID_W)
    col = jnp.tile(jnp.arange(GRID_W, dtype=jnp.float32), rows)
    axis_dim = ATTN_HEAD_DIM // 2
    inv_freq = ROPE_THETA ** (-jnp.arange(0, axis_dim, 2, dtype=jnp.float32) / axis_dim)
    ang_row = row[:, None] * inv_freq[None, :]
    ang_col = col[:, None] * inv_freq[None, :]
    return (jnp.cos(ang_row), jnp.sin(ang_row), jnp.cos(ang_col), jnp.sin(ang_col))


def rotate_pairs(x, cos, sin):
    x1, x2 = jnp.split(x, 2, axis=-1)
    cos = cos[:, None, :]
    sin = sin[:, None, :]
    return jnp.concatenate([x1 * cos - x2 * sin, x2 * cos + x1 * sin], axis=-1)


def apply_axial_rope(x, tables):
    cos_r, sin_r, cos_c, sin_c = tables
    x_row, x_col = jnp.split(x.astype(jnp.float32), 2, axis=-1)
    out = jnp.concatenate([rotate_pairs(x_row, cos_r, sin_r), rotate_pairs(x_col, cos_c, sin_c)], axis=-1)
    return out.astype(x.dtype)


def axial_gqa_attention(q, k, v, q_g, k_g, tables):
    B, S, _ = q.shape
    G = ATTN_HEADS // ATTN_KV_HEADS
    q = q.reshape(B, S, ATTN_HEADS, ATTN_HEAD_DIM)
    k = k.reshape(B, S, ATTN_KV_HEADS, ATTN_HEAD_DIM)
    v = v.reshape(B, S, ATTN_KV_HEADS, ATTN_HEAD_DIM)
    q = apply_axial_rope(rms_norm(q, q_g), tables)
    k = apply_axial_rope(rms_norm(k, k_g), tables)
    n_blocks = S // Q_BLOCK
    qb = q.reshape(B, n_blocks, Q_BLOCK, ATTN_KV_HEADS, G, ATTN_HEAD_DIM).transpose(1, 0, 3, 4, 2, 5)
    kt = k.transpose(0, 2, 1, 3)
    vt = v.transpose(0, 2, 1, 3)
    scale = ATTN_HEAD_DIM ** -0.5

    def one_block(q_blk):
        s = jnp.einsum('bkgqd,bksd->bkgqs', q_blk, kt).astype(jnp.float32) * scale
        p = jax.nn.softmax(s, axis=-1).astype(vt.dtype)
        return jnp.einsum('bkgqs,bksd->bkgqd', p, vt)

    o = lax.map(one_block, qb)
    return o.transpose(1, 0, 4, 2, 3, 5).reshape(B, S, ATTN_WIDTH)


def mlstm_chunkwise(q, k, v, i_pre, log_f):
    B, H, S, D = q.shape
    L = MLSTM_CHUNK
    nc = S // L

    def to_chunks(a):
        return jnp.moveaxis(a.reshape((B, H, nc, L) + a.shape[3:]), 2, 0)

    xs = (to_chunks(q), to_chunks(k), to_chunks(v), to_chunks(i_pre), to_chunks(log_f))
    tril = jnp.tril(jnp.ones((L, L), dtype=bool))

    def step(carry, chunk):
        C, n, m = carry
        qc, kc, vc, ic, fc = chunk
        b = jnp.cumsum(fc, axis=-1)
        g = b[..., -1]
        d = b[..., :, None] - b[..., None, :] + ic[..., None, :]
        d = jnp.where(tril, d, -jnp.inf)
        m_inter = b + m[..., None]
        m_t = jnp.maximum(m_inter, jnp.max(d, axis=-1))
        w_inter = jnp.exp(m_inter - m_t)
        p = jnp.exp(d - m_t[..., None])
        s = jnp.einsum('bhtd,bhsd->bhts', qc, kc) * p
        num = w_inter[..., None] * jnp.einsum('bhvd,bhtd->bhtv', C, qc) + jnp.einsum('bhts,bhsv->bhtv', s, vc)
        den = w_inter * jnp.einsum('bhd,bhtd->bht', n, qc) + jnp.sum(s, axis=-1)
        h = num / jnp.maximum(jnp.abs(den), jnp.exp(-m_t))[..., None]
        a = g[..., None] - b + ic
        m_new = jnp.maximum(g + m, jnp.max(a, axis=-1))
        decay = jnp.exp(g + m - m_new)
        w = jnp.exp(a - m_new[..., None])
        C = decay[..., None, None] * C + jnp.einsum('bhs,bhsv,bhsd->bhvd', w, vc, kc)
        n = decay[..., None] * n + jnp.einsum('bhs,bhsd->bhd', w, kc)
        return (C, n, m_new), h

    init = (jnp.zeros((B, H, D, D), jnp.float32), jnp.zeros((B, H, D), jnp.float32), jnp.zeros((B, H), jnp.float32))
    _, h = lax.scan(step, init, xs)
    return jnp.moveaxis(h, 0, 2).reshape(B, H, S, D)


def centred_depthwise_conv(x, w, b):
    ch = x.shape[-1]
    y = lax.conv_general_dilated(x, w[:, None, :].astype(x.dtype), window_strides=(1,),
                                 padding=[(CONV_WIDTH // 2, CONV_WIDTH // 2)],
                                 dimension_numbers=('NWC', 'WIO', 'NWC'), feature_group_count=ch)
    return y + b.astype(x.dtype)


def bidirectional_mlstm(qk_pre, v, o_pre, gate_pre, conv_w, conv_b, gate_b, norm_g):
    B, S, _ = v.shape
    qk = jax.nn.silu(centred_depthwise_conv(qk_pre, conv_w, conv_b))
    q, k = jnp.split(qk, 2, axis=-1)

    def heads(a):
        return a.astype(jnp.float32).reshape(B, S, MLSTM_HEADS, MLSTM_HEAD_DIM).transpose(0, 2, 1, 3)

    qh = heads(q)
    kh = heads(k) * MLSTM_HEAD_DIM ** -0.5
    vh = heads(v)
    g = (gate_pre.astype(jnp.float32) + gate_b.astype(jnp.float32)).reshape(B, S, 4, MLSTM_HEADS)
    g = g.transpose(2, 0, 3, 1)
    i_fw, f_fw, i_bw, f_bw = g[0], g[1], g[2], g[3]
    h_fw = mlstm_chunkwise(qh, kh, vh, i_fw, jax.nn.log_sigmoid(f_fw))
    flip = lambda a: jnp.flip(a, axis=2)
    h_bw = flip(mlstm_chunkwise(flip(qh), flip(kh), flip(vh), flip(i_bw), flip(jax.nn.log_sigmoid(f_bw))))
    h = (h_fw + h_bw).transpose(0, 2, 1, 3)
    h = h * lax.rsqrt(jnp.mean(h * h, axis=-1, keepdims=True) + EPS)
    h = h * norm_g.astype(jnp.float32).reshape(MLSTM_HEADS, MLSTM_HEAD_DIM)
    h = h.reshape(B, S, MLSTM_WIDTH) * jax.nn.sigmoid(o_pre.astype(jnp.float32))
    return h.astype(v.dtype)


def setup_inputs(seed: int = 0) -> dict:
    key = jax.random.key(seed)
    ks = jax.random.split(key, 18)
    nrm = lambda k, shape, s: jax.random.normal(k, shape, jnp.float32) * s
    gain = lambda k, shape: 1.0 + nrm(k, shape, 0.02)
    f_bias = jnp.linspace(FORGET_BIAS_LO, FORGET_BIAS_HI, MLSTM_HEADS, dtype=jnp.float32)
    gate_offset = jnp.zeros((4, MLSTM_HEADS), jnp.float32).at[1].set(f_bias).at[3].set(f_bias)
    gate_b = (nrm(ks[10], (DEPTH, 4, MLSTM_HEADS), 0.1) + gate_offset).reshape(DEPTH, N_GATES)
    return {
        'x': nrm(ks[0], (BATCH, SEQ, D_MODEL), 1.0),
        'c': nrm(ks[1], (BATCH, D_MODEL), 1.0),
        'w_ada': nrm(ks[2], (DEPTH, D_MODEL, 6 * D_MODEL), D_MODEL ** -0.5),
        'b_ada': nrm(ks[3], (DEPTH, 6 * D_MODEL), 0.02),
        'norm_mix_g': gain(ks[4], (DEPTH, D_MODEL)),
        'w_in': nrm(ks[5], (DEPTH, D_MODEL, IN_PROJ_WIDTH), D_MODEL ** -0.5),
        'q_norm_g': gain(ks[6], (DEPTH, ATTN_HEAD_DIM)),
        'k_norm_g': gain(ks[7], (DEPTH, ATTN_HEAD_DIM)),
        'conv_w': nrm(ks[8], (DEPTH, CONV_WIDTH, 2 * MLSTM_WIDTH), CONV_WIDTH ** -0.5),
        'conv_b': nrm(ks[9], (DEPTH, 2 * MLSTM_WIDTH), 0.02),
        'gate_b': gate_b,
        'mlstm_norm_g': gain(ks[11], (DEPTH, MLSTM_WIDTH)),
        'w_out': nrm(ks[12], (DEPTH, MIX_WIDTH, D_MODEL), MIX_WIDTH ** -0.5),
        'norm_ffn_g': gain(ks[13], (DEPTH, D_MODEL)),
        'w_gate': nrm(ks[14], (DEPTH, D_MODEL, FFN_HIDDEN), D_MODEL ** -0.5),
        'w_up': nrm(ks[15], (DEPTH, D_MODEL, FFN_HIDDEN), D_MODEL ** -0.5),
        'w_down': nrm(ks[16], (DEPTH, FFN_HIDDEN, D_MODEL), FFN_HIDDEN ** -0.5),
        'final_norm_g': gain(ks[17], (D_MODEL,)),
    }


def reference(x, c, w_ada, b_ada, norm_mix_g, w_in, q_norm_g, k_norm_g, conv_w, conv_b, gate_b,
              mlstm_norm_g, w_out, norm_ffn_g, w_gate, w_up, w_down, final_norm_g):
    S = x.shape[1]
    tables = axial_rope_tables(S)
    cond = jax.nn.silu(c)
    splits = [ATTN_WIDTH,
              ATTN_WIDTH + KV_WIDTH,
              ATTN_WIDTH + 2 * KV_WIDTH,
              ATTN_WIDTH + 2 * KV_WIDTH + 2 * MLSTM_WIDTH,
              ATTN_WIDTH + 2 * KV_WIDTH + 3 * MLSTM_WIDTH,
              ATTN_WIDTH + 2 * KV_WIDTH + 4 * MLSTM_WIDTH]
    for l in range(DEPTH):
        mod = cond @ w_ada[l] + b_ada[l]
        sh1, sc1, g1, sh2, sc2, g2 = jnp.split(mod, 6, axis=-1)
        h = modulate(rms_norm(x, norm_mix_g[l]), sh1, sc1)
        proj = h @ w_in[l]
        q_a, k_a, v_a, qk_m, v_m, o_m, gates = jnp.split(proj, splits, axis=-1)
        y_attn = axial_gqa_attention(q_a, k_a, v_a, q_norm_g[l], k_norm_g[l], tables)
        y_mem = bidirectional_mlstm(qk_m, v_m, o_m, gates, conv_w[l], conv_b[l], gate_b[l], mlstm_norm_g[l])
        mix = jnp.concatenate([y_attn, y_mem], axis=-1) @ w_out[l]
        x = x + g1[:, None, :] * mix
        h = modulate(rms_norm(x, norm_ffn_g[l]), sh2, sc2)
        ffn = (jax.nn.silu(h @ w_gate[l]) * (h @ w_up[l])) @ w_down[l]
        x = x + g2[:, None, :] * ffn
    return rms_norm(x, final_norm_g)
```

```cpp
#include <hip/hip_runtime.h>
#include <hip/hip_bf16.h>
#include <cstdio>
#include <cstdint>
#include <cmath>
#ifndef NAIVE_GEMM
#define NAIVE_GEMM 1
#endif
#ifndef NAIVE_ATTN
#define NAIVE_ATTN 1
#endif
#ifndef MK_N_LAUNCHES
#define MK_N_LAUNCHES 1
#endif
constexpr int NWAVES = 8, NTHREADS = NWAVES * 64;
constexpr int BATCH = 8, SEQ = 4096, DMODEL = 1024, M = BATCH * SEQ;
constexpr int NPROJ = 2816, NIN = 2832, FFH = 2816, NMOD = 6144;
constexpr float EPS = 1e-6f;
constexpr int N_LAUNCHES = MK_N_LAUNCHES;
constexpr int NPHASE = 10;
constexpr size_t MiB = 1u << 20;
constexpr size_t WS_CTL = 0, CTL_ZERO_BYTES = 1 * MiB;
constexpr int CW_TMO = 0, CW_CODE = 1, CW_BAR = 4096, CW_QUEUE = 8192;
constexpr size_t WS_MOD = 512 * 1024;
constexpr size_t WS_TABC = 1 * MiB, WS_TABS = 1 * MiB + 4096, WS_QKG = 1 * MiB + 8192, WS_WGT = 1 * MiB + 65536;
constexpr size_t WS_WIN = 2 * MiB, WS_WO = 8 * MiB, WS_WGU = 10 * MiB, WS_WD = 22 * MiB;
constexpr size_t WS_XN = 32 * MiB, WS_Q = 96 * MiB, WS_K = 128 * MiB, WS_V = 136 * MiB, WS_QKM = 144 * MiB, WS_VM = 208 * MiB, WS_OM = 240 * MiB;
constexpr size_t WS_GATES = 272 * MiB, WS_Y = 276 * MiB, WS_HF = 340 * MiB, WS_END = 468 * MiB;
constexpr size_t WS_ACT = 96 * MiB;
static_assert(WS_ACT + (size_t)M * FFH * 2 <= WS_GATES, "ACT overlay");
constexpr int RING_BYTES = 131072, LDSCTL_OFF = RING_BYTES, MISC_OFF = LDSCTL_OFF + 320, LDS_BYTES = 147456;
#ifdef XB_SPIN_CAP
#undef XB_SPIN_CAP
#endif
#define XB_SPIN_CAP (1u << 26)

namespace pg8 {
#define PG8_LAS __attribute__((address_space(3)))
typedef unsigned short bf16_t;
typedef short bf16x8 __attribute__((ext_vector_type(8)));
typedef float f32x4 __attribute__((ext_vector_type(4)));
typedef unsigned u32x4 __attribute__((ext_vector_type(4)));
constexpr int BM = 256, BK = 64, HALF = 128, HTB = HALF * BK * 2  , STAGE_BYTES = 8 * HTB, NXCD = 8, WGM = 8;

__host__ __device__ __forceinline__ int lds_byte(int r, int c) { const int st = (r >> 4) * 2 + (c >> 5), rr = r & 15, cc = c & 31, ob = rr * 64 + cc * 2; return st * 1024 + (ob ^ (((ob >> 9) & 1) << 5)); }
__host__ __device__ __forceinline__ void stage_rc(int b, int& R, int& C) { const int st = b / 1024, sb = b % 1024, swz = sb ^ (((sb >> 9) & 1) << 5); R = (st >> 1) * 16 + swz / 64; C = (st & 1) * 32 + (swz % 64) / 2; }
__host__ __device__ __forceinline__ int perm32(int rho) { const int n = rho >> 4, i = rho & 15; return 8 * (i >> 2) + 4 * n + (i & 3); }

struct Unit { int pm, pn; };
struct Gemm { const bf16_t* A; const bf16_t* Bt; int M, N, K; };

struct StaticOrder {
    int nM, nN, nwg, G, c;
    __host__ __device__ void init(int M, int N, int G_, int c_) { nM = M / BM; nN = N / BM; nwg = nM * nN; G = G_; c = c_; }
    __host__ __device__ bool next(int i, Unit& u) const {
        const long L = (long)i * G + c; if (L >= nwg) return false;
        int wgid = (int)L; { const int q = nwg / NXCD, r = nwg % NXCD, xcd = wgid % NXCD, off = wgid / NXCD; wgid = (xcd < r ? xcd * (q + 1) : r * (q + 1) + (xcd - r) * q) + off; }
        const int nig = WGM * nN, gid = wgid / nig, fm = gid * WGM, gsz = (nM - fm) < WGM ? (nM - fm) : WGM;
        u.pm = fm + ((wgid % nig) % gsz); u.pn = (wgid % nig) / gsz; return true;
    }
    __device__ __forceinline__ void a_ready(const Unit&) const {}
    __device__ __forceinline__ void done(const Unit&) const {}
};

__device__ __forceinline__ unsigned cvt_pk_bf16(float lo, float hi) { unsigned r; asm volatile("v_cvt_pk_bf16_f32 %0, %1, %2" : "=v"(r) : "v"(lo), "v"(hi)); return r; }
typedef float f32x2 __attribute__((ext_vector_type(2)));
template <class Epi, class Sched, bool ALIGN_EPI = false, bool SP2 = false>
__device__ __forceinline__ void gemm_phase(PG8_LAS unsigned char* lds, const Gemm g, const Sched& S, const Epi& E) {
    const int tid = threadIdx.x, wid = __builtin_amdgcn_readfirstlane(tid >> 6), lane = tid & 63, wr = wid >> 2, wc = wid & 3, fr = lane & 15, fq = lane >> 4;
    const int K = g.K, nt = K / BK;
    unsigned voffA[2], voffB[2];
#pragma unroll
    for (int i = 0; i < 2; ++i) { int R, C; stage_rc(tid * 16 + i * 8192, R, C); const int Rb = Epi::PERM ? ((R & ~31) + perm32(R & 31)) : R;
        voffA[i] = (unsigned)(R * K + C) * 2u; voffB[i] = (unsigned)(Rb * K + C) * 2u; }
    const size_t kstep = (size_t)(BK * 2);
    const size_t hstep = (size_t)HALF * K * 2;
    const size_t tstep = 2 * hstep;
    const unsigned ldsw = (unsigned)wid * 1024u;
    const int aoff = lds_byte(wr * 64 + fr, fq * 8), boff = lds_byte(wc * 32 + fr, fq * 8);
#define PG8_SA(b, h) (((b) * 2 + (h)) * HTB)
#define PG8_SB(b, h) ((4 + (b) * 2 + (h)) * HTB)
#define PG8_STAGE(bufoff, gbase, voff) do { _Pragma("unroll") for (int _i = 0; _i < 2; ++_i) \
        __builtin_amdgcn_global_load_lds((const unsigned*)((const char*)(gbase) + (voff)[_i]), (PG8_LAS unsigned*)(lds + (bufoff) + ldsw + _i * 8192), 16, 0, 0); } while (0)
#define PG8_LDA(dst, b, h) do { _Pragma("unroll") for (int m = 0; m < 4; ++m) _Pragma("unroll") for (int k = 0; k < 2; ++k) dst[m][k] = *(const PG8_LAS bf16x8*)(lds + PG8_SA(b, h) + aoff + m * 2048 + k * 1024); } while (0)
#define PG8_LDB(dst, b, h) do { _Pragma("unroll") for (int n = 0; n < 2; ++n) _Pragma("unroll") for (int k = 0; k < 2; ++k) dst[n][k] = *(const PG8_LAS bf16x8*)(lds + PG8_SB(b, h) + boff + n * 2048 + k * 1024); } while (0)
#define PG8_MMA(ai, bj, At, Bt) do { __builtin_amdgcn_s_setprio(1); _Pragma("unroll") for (int m = 0; m < 4; ++m) _Pragma("unroll") for (int n = 0; n < 2; ++n) _Pragma("unroll") for (int k = 0; k < 2; ++k) \
        acc[ai][bj][m][n] = __builtin_amdgcn_mfma_f32_16x16x32_bf16(Bt[n][k], At[m][k], acc[ai][bj][m][n], 0, 0, 0); __builtin_amdgcn_s_setprio(0); } while (0)
#define PG8_WAIT_V(n) asm volatile("s_waitcnt vmcnt(" #n ")" ::: "memory")
#define PG8_WAIT_L(n) asm volatile("s_waitcnt lgkmcnt(" #n ")" ::: "memory")
#define PG8_BAR __builtin_amdgcn_s_barrier()
#define PG8_SCHED __builtin_amdgcn_sched_barrier(0)
    Unit cur, nxt; int ui = 0;
    if (!S.next(0, cur)) return;
    f32x4 acc[2][2][4][2];
#pragma unroll
    for (int a = 0; a < 2; ++a)
#pragma unroll
        for (int b = 0; b < 2; ++b)
#pragma unroll
            for (int m = 0; m < 4; ++m)
#pragma unroll
                for (int n = 0; n < 2; ++n) acc[a][b][m][n] = (f32x4){0.f, 0.f, 0.f, 0.f};
    bf16x8 At[4][2], B0[2][2], B1[2][2];
    const char* cA = (const char*)g.A + (size_t)cur.pm * tstep; const char* cB = (const char*)g.Bt + (size_t)cur.pn * tstep;
    S.a_ready(cur);
    if constexpr (SP2) {
        PG8_STAGE(PG8_SB(0, 0), cB, voffB); PG8_STAGE(PG8_SB(0, 1), cB + hstep, voffB); PG8_STAGE(PG8_SA(0, 0), cA, voffA); PG8_STAGE(PG8_SA(0, 1), cA + hstep, voffA);
        if (wr == 1) PG8_BAR;
        PG8_WAIT_V(2); PG8_BAR;
        PG8_STAGE(PG8_SB(1, 0), cB + kstep, voffB); PG8_STAGE(PG8_SA(1, 0), cA + kstep, voffA); PG8_STAGE(PG8_SB(1, 1), cB + hstep + kstep, voffB);
        PG8_WAIT_V(6); PG8_BAR;
    } else {
        PG8_STAGE(PG8_SB(0, 0), cB, voffB); PG8_STAGE(PG8_SA(0, 0), cA, voffA); PG8_STAGE(PG8_SB(0, 1), cB + hstep, voffB); PG8_STAGE(PG8_SA(0, 1), cA + hstep, voffA);
        if (wr == 1) PG8_BAR;
        PG8_WAIT_V(4); PG8_BAR;
        PG8_STAGE(PG8_SB(1, 0), cB + kstep, voffB); PG8_STAGE(PG8_SA(1, 0), cA + kstep, voffA); PG8_STAGE(PG8_SB(1, 1), cB + hstep + kstep, voffB);
        PG8_WAIT_V(6); PG8_BAR;
    }
    for (;;) {
        const bool has_next = S.next(ui + 1, nxt);
        const char* nA = has_next ? (const char*)g.A + (size_t)nxt.pm * tstep : cA; const char* nB = has_next ? (const char*)g.Bt + (size_t)nxt.pn * tstep : cB;
        for (int t = 0; t < nt; t += 2) {
            const bool last = (t == nt - 2);
            const char* a1 = cA + (size_t)(t + 1) * kstep;
            const char* a2 = last ? nA : cA + (size_t)(t + 2) * kstep; const char* b2 = last ? nB : cB + (size_t)(t + 2) * kstep;
            const char* a3 = a2 + kstep; const char* b3 = b2 + kstep;
            if (last && has_next) S.a_ready(nxt);
            if constexpr (SP2) {
            PG8_LDB(B0, 0, 0); PG8_LDB(B1, 0, 1); PG8_SCHED; PG8_LDA(At, 0, 0); PG8_STAGE(PG8_SA(1, 1), a1 + hstep, voffA);
            PG8_WAIT_V(8); PG8_WAIT_L(0); PG8_BAR; PG8_MMA(0, 0, At, B0); PG8_MMA(0, 1, At, B1); PG8_BAR; PG8_SCHED;
            PG8_LDA(At, 0, 1); PG8_STAGE(PG8_SB(0, 0), b2, voffB); PG8_STAGE(PG8_SB(0, 1), b2 + hstep, voffB); PG8_STAGE(PG8_SA(0, 0), a2, voffA);
            PG8_WAIT_V(8); PG8_WAIT_L(0); PG8_BAR; PG8_MMA(1, 0, At, B0); PG8_MMA(1, 1, At, B1); PG8_BAR; PG8_SCHED;
            PG8_LDB(B0, 1, 0); PG8_LDB(B1, 1, 1); PG8_SCHED; PG8_LDA(At, 1, 0); PG8_STAGE(PG8_SA(0, 1), a2 + hstep, voffA);
            PG8_WAIT_V(8); PG8_WAIT_L(0); PG8_BAR; PG8_MMA(0, 0, At, B0); PG8_MMA(0, 1, At, B1); PG8_BAR; PG8_SCHED;
            PG8_LDA(At, 1, 1); PG8_STAGE(PG8_SB(1, 0), b3, voffB); PG8_STAGE(PG8_SB(1, 1), b3 + hstep, voffB); PG8_STAGE(PG8_SA(1, 0), a3, voffA);
            PG8_WAIT_V(8); PG8_WAIT_L(0); PG8_BAR; PG8_MMA(1, 0, At, B0); PG8_MMA(1, 1, At, B1); PG8_BAR; PG8_SCHED;
            } else {
            PG8_LDB(B0, 0, 0); PG8_SCHED; PG8_LDA(At, 0, 0); PG8_STAGE(PG8_SA(1, 1), a1 + hstep, voffA);
            PG8_WAIT_L(8); PG8_BAR; PG8_WAIT_L(0); PG8_MMA(0, 0, At, B0); PG8_BAR; PG8_SCHED;
            PG8_LDB(B1, 0, 1); PG8_STAGE(PG8_SB(0, 0), b2, voffB);
            PG8_BAR; PG8_WAIT_L(0); PG8_MMA(0, 1, At, B1); PG8_BAR;
            PG8_LDA(At, 0, 1); PG8_STAGE(PG8_SA(0, 0), a2, voffA);
            PG8_BAR; PG8_WAIT_L(0); PG8_MMA(1, 0, At, B0); PG8_BAR; PG8_SCHED;
            PG8_STAGE(PG8_SB(0, 1), b2 + hstep, voffB);
            PG8_WAIT_V(6); PG8_BAR; PG8_MMA(1, 1, At, B1); PG8_BAR;
            PG8_LDB(B0, 1, 0); PG8_SCHED; PG8_LDA(At, 1, 0); PG8_STAGE(PG8_SA(0, 1), a2 + hstep, voffA);
            PG8_WAIT_L(8); PG8_BAR; PG8_WAIT_L(0); PG8_MMA(0, 0, At, B0); PG8_BAR; PG8_SCHED;
            PG8_LDB(B1, 1, 1); PG8_STAGE(PG8_SB(1, 0), b3, voffB);
            PG8_BAR; PG8_WAIT_L(0); PG8_MMA(0, 1, At, B1); PG8_BAR;
            PG8_LDA(At, 1, 1); PG8_STAGE(PG8_SA(1, 0), a3, voffA);
            PG8_BAR; PG8_WAIT_L(0); PG8_MMA(1, 0, At, B0); PG8_BAR; PG8_SCHED;
            PG8_STAGE(PG8_SB(1, 1), b3 + hstep, voffB);
            PG8_WAIT_V(6); PG8_BAR; PG8_MMA(1, 1, At, B1); PG8_BAR;
            }
        }
        if constexpr (ALIGN_EPI) { if (wr == 0) PG8_BAR; }
        if constexpr (!Epi::AFTER_DRAIN) { E(acc, cur, wr, wc, fr, fq); S.done(cur); }
        if (!has_next) break;
#pragma unroll
        for (int a = 0; a < 2; ++a)
#pragma unroll
            for (int b = 0; b < 2; ++b)
#pragma unroll
                for (int m = 0; m < 4; ++m)
#pragma unroll
                    for (int n = 0; n < 2; ++n) acc[a][b][m][n] = (f32x4){0.f, 0.f, 0.f, 0.f};
        cur = nxt; cA = nA; cB = nB; ++ui;
        if constexpr (ALIGN_EPI) { if (wr == 1) PG8_BAR; }
    }
    PG8_WAIT_V(0);
    if constexpr (!ALIGN_EPI) { if (wr == 0) PG8_BAR; }
    PG8_BAR;
    if constexpr (Epi::AFTER_DRAIN) { E.fused(acc, cur, wr, wc, fr, fq, lds, wid, lane); S.done(cur); }
#undef PG8_SA
#undef PG8_SB
#undef PG8_STAGE
#undef PG8_LDA
#undef PG8_LDB
#undef PG8_MMA
#undef PG8_WAIT_V
#undef PG8_WAIT_L
#undef PG8_BAR
#undef PG8_SCHED
}
typedef unsigned u32x2 __attribute__((ext_vector_type(2)));
constexpr float ATT_C2 = 0.125f * 1.4426950408889634f;
struct EpiInProj {
    static constexpr bool PERM = false, AFTER_DRAIN = false;
    unsigned char* ws;
    __device__ __forceinline__ void operator()(const f32x4 (&acc)[2][2][4][2], const Unit& u, int wr, int wc, int fr, int fq) const {
        const int pn = u.pn, row0 = u.pm * BM + wr * 64 + fr;
        if (pn >= 3) {
            const size_t boff = (pn < 7) ? WS_QKM : ((pn < 9) ? WS_VM : WS_OM);
            const int ldc = (pn < 7) ? 1024 : 512, c0 = 256 * ((pn < 7) ? (pn - 3) : ((pn < 9) ? (pn - 7) : (pn - 9))) + wc * 32 + 8 * fq;
            bf16_t* base = (bf16_t*)(ws + boff);
#pragma unroll
            for (int ai = 0; ai < 2; ++ai)
#pragma unroll
                for (int m = 0; m < 4; ++m) { bf16_t* rowp = base + (size_t)(row0 + ai * HALF + m * 16) * ldc + c0;
#pragma unroll
                    for (int bj = 0; bj < 2; ++bj) { const f32x4 v0 = acc[ai][bj][m][0], v1 = acc[ai][bj][m][1]; u32x4 w;
                        w.x = cvt_pk_bf16(v0[0], v0[1]); w.y = cvt_pk_bf16(v0[2], v0[3]); w.z = cvt_pk_bf16(v1[0], v1[1]); w.w = cvt_pk_bf16(v1[2], v1[3]);
                        *(u32x4*)(rowp + bj * HALF) = w; } }
            return;
        }
        const bool isv = (pn == 2 && wc >= 2), isq = (pn < 2);
        const size_t boff = isq ? WS_Q : (isv ? WS_V : WS_K);
        const int ldc = isq ? 512 : 128, hcol = isq ? (4 * pn + wc) * 64 : (wc & 1) * 64;
        bf16_t* base = (bf16_t*)(ws + boff);
        const float* g = (const float*)(ws + WS_QKG) + (isq ? 0 : 64);
        const float* tabc = (const float*)(ws + WS_TABC); const float* tabs = (const float*)(ws + WS_TABS);
        f32x4 gv[4];
#pragma unroll
        for (int dq = 0; dq < 4; ++dq) gv[dq] = *(const f32x4*)(g + 16 * dq + 4 * fq);
        const float osc = isq ? ATT_C2 : 1.0f;
#pragma unroll
        for (int ai = 0; ai < 2; ++ai)
#pragma unroll
            for (int m = 0; m < 4; ++m) {
                const int r = row0 + ai * HALF + m * 16;
                f32x4 y[4];
#pragma unroll
                for (int dq = 0; dq < 4; ++dq) y[dq] = acc[ai][dq >> 1][m][dq & 1];
                if (!isv) {
                    float ss = 0.f;
#pragma unroll
                    for (int dq = 0; dq < 4; ++dq) ss += (y[dq][0] * y[dq][0] + y[dq][1] * y[dq][1]) + (y[dq][2] * y[dq][2] + y[dq][3] * y[dq][3]);
                    ss += __shfl_xor(ss, 16); ss += __shfl_xor(ss, 32);
                    const float rstd = 1.0f / sqrtf(ss * (1.0f / 64.0f) + 1e-6f);
#pragma unroll
                    for (int dq = 0; dq < 4; ++dq) y[dq] = y[dq] * rstd * gv[dq];
                    const int t = r & 4095, pr = t >> 6, pc = t & 63;
                    const f32x4 cr = *(const f32x4*)(tabc + pr * 16 + 4 * fq), sr = *(const f32x4*)(tabs + pr * 16 + 4 * fq);
                    const f32x4 cc = *(const f32x4*)(tabc + pc * 16 + 4 * fq), sc = *(const f32x4*)(tabs + pc * 16 + 4 * fq);
                    const f32x4 o0 = y[0] * cr - y[1] * sr, o1 = y[1] * cr + y[0] * sr, o2 = y[2] * cc - y[3] * sc, o3 = y[3] * cc + y[2] * sc;
                    y[0] = o0 * osc; y[1] = o1 * osc; y[2] = o2 * osc; y[3] = o3 * osc;
                }
                bf16_t* rowp = base + (size_t)r * ldc + hcol + 4 * fq;
#pragma unroll
                for (int dq = 0; dq < 4; ++dq) { u32x2 w; w.x = cvt_pk_bf16(y[dq][0], y[dq][1]); w.y = cvt_pk_bf16(y[dq][2], y[dq][3]); *(u32x2*)(rowp + 16 * dq) = w; }
            }
    }
};
struct EpiResGate {
    static constexpr bool PERM = false, AFTER_DRAIN = false;
    const float* base; float* out; const float* gate;
    __device__ __forceinline__ void operator()(const f32x4 (&acc)[2][2][4][2], const Unit& u, int wr, int wc, int fr, int fq) const {
        const int row0 = u.pm * BM + wr * 64 + fr, col0 = u.pn * BM + wc * 32 + 4 * fq, b = (u.pm * BM) >> 12;
        f32x4 gv[2][2];
#pragma unroll
        for (int bj = 0; bj < 2; ++bj)
#pragma unroll
            for (int n = 0; n < 2; ++n) gv[bj][n] = *(const f32x4*)(gate + (size_t)b * 6144 + col0 + bj * HALF + n * 16);
#pragma unroll
        for (int ai = 0; ai < 2; ++ai)
#pragma unroll
            for (int m = 0; m < 4; ++m) { const size_t off = (size_t)(row0 + ai * HALF + m * 16) * 1024 + col0;
#pragma unroll
                for (int bj = 0; bj < 2; ++bj)
#pragma unroll
                    for (int n = 0; n < 2; ++n) { const f32x4 bs = *(const f32x4*)(base + off + bj * HALF + n * 16); *(f32x4*)(out + off + bj * HALF + n * 16) = bs + gv[bj][n] * acc[ai][bj][m][n]; } }
    }
};
struct EpiSwiGLU {
    static constexpr bool PERM = false, AFTER_DRAIN = false;
    bf16_t* act;
    __device__ __forceinline__ void operator()(const f32x4 (&acc)[2][2][4][2], const Unit& u, int wr, int wc, int fr, int fq) const {
        const int row0 = u.pm * BM + wr * 64 + fr, c0 = u.pn * HALF + wc * 32 + 8 * fq;
#pragma unroll
        for (int ai = 0; ai < 2; ++ai)
#pragma unroll
            for (int m = 0; m < 4; ++m) { float o[8];
#pragma unroll
                for (int n = 0; n < 2; ++n)
#pragma unroll
                    for (int e = 0; e < 4; ++e) { const float gt = acc[ai][0][m][n][e], up = acc[ai][1][m][n][e];
                        o[4 * n + e] = gt * __builtin_amdgcn_rcpf(1.0f + __builtin_amdgcn_exp2f(-1.4426950408889634f * gt)) * up; }
                u32x4 w; w.x = cvt_pk_bf16(o[0], o[1]); w.y = cvt_pk_bf16(o[2], o[3]); w.z = cvt_pk_bf16(o[4], o[5]); w.w = cvt_pk_bf16(o[6], o[7]);
                *(u32x4*)(act + (size_t)(row0 + ai * HALF + m * 16) * 2816 + c0) = w; }
    }
};
template <class Epi, class Sched>
__device__ __forceinline__ void gemm_simple(const Gemm g, const Sched& S, const Epi& E) {
    const int tid = threadIdx.x, wid = __builtin_amdgcn_readfirstlane(tid >> 6), lane = tid & 63, wr = wid >> 2, wc = wid & 3, fr = lane & 15, fq = lane >> 4;
    const int K = g.K; Unit u;
    for (int i = 0; S.next(i, u); ++i) {
        f32x4 acc[2][2][4][2];
#pragma unroll
        for (int a = 0; a < 2; ++a)
#pragma unroll
            for (int b = 0; b < 2; ++b)
#pragma unroll
                for (int m = 0; m < 4; ++m)
#pragma unroll
                    for (int n = 0; n < 2; ++n) acc[a][b][m][n] = (f32x4){0.f, 0.f, 0.f, 0.f};
        const bf16_t* Ab = g.A + (size_t)(u.pm * BM + wr * 64 + fr) * K + fq * 8;
        const bf16_t* Bb = g.Bt + (size_t)(u.pn * BM + wc * 32 + fr) * K + fq * 8;
        for (int k0 = 0; k0 < K; k0 += 32) {
            bf16x8 a[2][4], b[2][2];
#pragma unroll
            for (int ai = 0; ai < 2; ++ai)
#pragma unroll
                for (int m = 0; m < 4; ++m) a[ai][m] = *(const bf16x8*)(Ab + (size_t)(ai * HALF + m * 16) * K + k0);
#pragma unroll
            for (int bj = 0; bj < 2; ++bj)
#pragma unroll
                for (int n = 0; n < 2; ++n) b[bj][n] = *(const bf16x8*)(Bb + (size_t)(bj * HALF + n * 16) * K + k0);
#pragma unroll
            for (int ai = 0; ai < 2; ++ai)
#pragma unroll
                for (int bj = 0; bj < 2; ++bj)
#pragma unroll
                    for (int m = 0; m < 4; ++m)
#pragma unroll
                        for (int n = 0; n < 2; ++n) acc[ai][bj][m][n] = __builtin_amdgcn_mfma_f32_16x16x32_bf16(b[bj][n], a[ai][m], acc[ai][bj][m][n], 0, 0, 0);
        }
        E(acc, u, wr, wc, fr, fq);
    }
}
}
#ifndef PG8_SP2
#define PG8_SP2 true
#endif
#ifndef PG8_ALIGN
#define PG8_ALIGN true
#endif
#include <hip/hip_bf16.h>
#include <cmath>
namespace attn_body {
using bf16=__hip_bfloat16;
using bf16x8=__attribute__((ext_vector_type(8)))short;
using s16x4=__attribute__((ext_vector_type(4)))short;
using f32x16=__attribute__((ext_vector_type(16)))float;
using u32x4=__attribute__((ext_vector_type(4)))unsigned;
constexpr int BATCH=8,NHEAD=8,NKV=2,SEQ=4096,D=64,QP=512,KP=128,OP=1024;
constexpr int NW=8,QBLK=32,QB=QBLK*NW,KVBLK=64,NQB=SEQ/QB;
constexpr int ATTN_UNIT_ROWS=QB;
__device__ __forceinline__ int crow(int r,int hi){return (r&3)+8*(r>>2)+4*hi;}
#define SBAR() __builtin_amdgcn_sched_barrier(0)
__device__ __forceinline__ void cmask(f32x16&p0,f32x16&p1,int jb,int qrel,int hi){
  const float NEG=-INFINITY; int kb=64*jb+4*hi;
  #pragma unroll
  for(int r=0;r<16;++r){int kv=kb+(r&3)+8*(r>>2); if(kv>qrel)p0[r]=NEG; if(kv+32>qrel)p1[r]=NEG;}
}

constexpr int NSLOT=3, SLOTB=8192;
constexpr int LDS_K=0, LDS_V=NSLOT*SLOTB, LDS_WS=2*NSLOT*SLOTB, LDS_OST=LDS_WS+NW*64*4, LDS_BYTES=LDS_OST+NW*4096;
constexpr float C2=0.125f*1.4426950408889634f;
__device__ __forceinline__ void glds16(const void*gsrc,unsigned lds_dst){unsigned keep;
  asm volatile("s_mov_b32 %0, m0\n\ts_mov_b32 m0, %2\n\ts_nop 0\n\tglobal_load_lds_dwordx4 %1, off\n\ts_mov_b32 m0, %0":"=&s"(keep):"v"(gsrc),"s"(lds_dst):"memory");}
__device__ __forceinline__ float max3f(float a,float b,float c){float r;asm("v_max3_f32 %0, %1, %2, %3":"=v"(r):"v"(a),"v"(b),"v"(c));return r;}
__device__ __forceinline__ float max2f(float a,float b){float r;asm("v_max_f32_e32 %0, %1, %2":"=v"(r):"v"(a),"v"(b));return r;}
__device__ __forceinline__ float fadd_s(float a,float b){float r;asm("v_add_f32_e32 %0, %1, %2":"=v"(r):"v"(a),"v"(b));return r;}
__device__ __forceinline__ float fsub_s(float a,float b){float r;asm("v_sub_f32_e32 %0, %1, %2":"=v"(r):"v"(a),"v"(b));return r;}
typedef float f32x2_t __attribute__((ext_vector_type(2))); typedef __bf16 bf16x2_t __attribute__((ext_vector_type(2)));
__device__ __forceinline__ unsigned cvtpk_s(float lo,float hi){f32x2_t v={lo,hi};bf16x2_t b=__builtin_convertvector(v,bf16x2_t);return __builtin_bit_cast(unsigned,b);}
#define WAIT_BAR(N) asm volatile("s_waitcnt vmcnt(" #N ") lgkmcnt(0)\n\ts_barrier":::"memory")

__device__ __forceinline__ void qkt(f32x16&p0,f32x16&p1,const char*Kslot,const bf16x8*qr,const f32x16&negm,int r32,int hi){
  const char*kb=Kslot+hi*1024+r32*16;
  #pragma unroll
  for(int d0=0;d0<4;++d0){
    const bf16x8 b0=*reinterpret_cast<const bf16x8*>(kb+d0*2048);
    const bf16x8 b1=*reinterpret_cast<const bf16x8*>(kb+d0*2048+512);
    if(d0==0){p0=__builtin_amdgcn_mfma_f32_32x32x16_bf16(b0,qr[0],negm,0,0,0);p1=__builtin_amdgcn_mfma_f32_32x32x16_bf16(b1,qr[0],negm,0,0,0);}
    else{p0=__builtin_amdgcn_mfma_f32_32x32x16_bf16(b0,qr[d0],p0,0,0,0);p1=__builtin_amdgcn_mfma_f32_32x32x16_bf16(b1,qr[d0],p1,0,0,0);}}
}
typedef __attribute__((address_space(3))) const char* lds_cptr;
typedef short v4i16_t __attribute__((ext_vector_type(4)));
__device__ __forceinline__ void kload8(bf16x8*kf,lds_cptr kp){
  kf[0]=*(const __attribute__((address_space(3))) bf16x8*)(kp);      kf[1]=*(const __attribute__((address_space(3))) bf16x8*)(kp+512);
  kf[2]=*(const __attribute__((address_space(3))) bf16x8*)(kp+2048); kf[3]=*(const __attribute__((address_space(3))) bf16x8*)(kp+2560);
  kf[4]=*(const __attribute__((address_space(3))) bf16x8*)(kp+4096); kf[5]=*(const __attribute__((address_space(3))) bf16x8*)(kp+4608);
  kf[6]=*(const __attribute__((address_space(3))) bf16x8*)(kp+6144); kf[7]=*(const __attribute__((address_space(3))) bf16x8*)(kp+6656);
}
__device__ __forceinline__ void kload2(bf16x8*kf,lds_cptr kp,int j){ kf[2*j]=*(const __attribute__((address_space(3))) bf16x8*)(kp+j*2048); kf[2*j+1]=*(const __attribute__((address_space(3))) bf16x8*)(kp+j*2048+512); }
__device__ __forceinline__ s16x4 vtr(lds_cptr p){ return __builtin_bit_cast(s16x4,__builtin_amdgcn_ds_read_tr16_b64_v4i16((__attribute__((address_space(3))) v4i16_t*)p)); }
__device__ __forceinline__ float rowmax(const f32x16&p0,const f32x16&p1){
  float a=max3f(p0[0],p0[1],p1[0]),b=max3f(p0[2],p0[3],p1[1]);a=max3f(a,p1[2],p1[3]);
  #pragma unroll
  for(int r=4;r<16;r+=4){a=max3f(a,p0[r],p0[r+1]);b=max3f(b,p0[r+2],p0[r+3]);a=max3f(a,p1[r],p1[r+1]);b=max3f(b,p1[r+2],p1[r+3]);}
  const float m=max2f(a,b);
  auto rr=__builtin_amdgcn_permlane32_swap(__float_as_uint(m),__float_as_uint(m),false,false);
  return max2f(__uint_as_float(rr[0]),__uint_as_float(rr[1]));
}
__device__ __forceinline__ void pv(f32x16*o,int vb,bf16x8 pa0,bf16x8 pa1,bf16x8 pa2,bf16x8 pa3){
  #pragma unroll
  for(int d0=0;d0<2;++d0){s16x4 lo[4],hi[4];
    #pragma unroll
    for(int ks=0;ks<4;++ks){
      asm volatile("ds_read_b64_tr_b16 %0,%1 offset:%c2":"=&v"(lo[ks]):"v"(vb),"i"(d0*4096+ks*1024):"memory");
      asm volatile("ds_read_b64_tr_b16 %0,%1 offset:%c2":"=&v"(hi[ks]):"v"(vb),"i"(d0*4096+ks*1024+512):"memory");}
    asm volatile("s_waitcnt lgkmcnt(0)":::"memory");SBAR();
    #define PK(k) (bf16x8){lo[k][0],lo[k][1],lo[k][2],lo[k][3],hi[k][0],hi[k][1],hi[k][2],hi[k][3]}
    o[d0]=__builtin_amdgcn_mfma_f32_32x32x16_bf16(pa0,PK(0),o[d0],0,0,0);
    o[d0]=__builtin_amdgcn_mfma_f32_32x32x16_bf16(pa1,PK(1),o[d0],0,0,0);
    o[d0]=__builtin_amdgcn_mfma_f32_32x32x16_bf16(pa2,PK(2),o[d0],0,0,0);
    o[d0]=__builtin_amdgcn_mfma_f32_32x32x16_bf16(pa3,PK(3),o[d0],0,0,0);
    #undef PK
  }
}

#ifndef ATTN_STORE16
#define ATTN_STORE16(p,v) (*(u32x4*)(p)=(v))
#endif
template<int THRL> __device__ __forceinline__ void attn_unit(int b,int h,int qb,const bf16*Q,const bf16*__restrict__ K,const bf16*__restrict__ V,bf16*O,char*shm){
  const int tid=threadIdx.x,lane=tid&63,r32=lane&31,hi=lane>>5; const int wid=__builtin_amdgcn_readfirstlane(tid>>6);
  const long rowbase=(long)b*SEQ; const int q0=qb*QB;
  const bf16*Qw=Q+(rowbase+q0+wid*QBLK)*QP+h*D;
  const int kvh=h/(NHEAD/NKV); const bf16*Kh=K+rowbase*KP+kvh*D,*Vh=V+rowbase*KP+kvh*D;
  const unsigned lds0=(unsigned)(uintptr_t)shm;
  float*wsf=(float*)(shm+LDS_WS)+wid*64;
  const bf16*ksrc=Kh+(long)lane*KP+wid*8;
  const bf16*vsrc=Vh+(long)(16*(wid&3)+(lane>>2))*KP+(wid>>2)*32+(lane&3)*8;
  const unsigned kdst=lds0+LDS_K+wid*1024, vdst=lds0+LDS_V+wid*1024;
  #define DMA_K(t,slot) glds16(ksrc+(long)(t)*KVBLK*KP,(unsigned)__builtin_amdgcn_readfirstlane(kdst+(slot)))
  #define DMA_V(t,slot) glds16(vsrc+(long)(t)*KVBLK*KP,(unsigned)__builtin_amdgcn_readfirstlane(vdst+(slot)))
  const int vb0=(int)(lds0+LDS_V)+((lane>>4)&1)*32+(lane&3)*8+(4*hi+((lane&15)>>2))*64;
  const char*Kbase=shm+LDS_K; bf16x8 kf[8];
  const lds_cptr shm3=(lds_cptr)shm; const lds_cptr kp0=shm3+LDS_K+hi*1024+r32*16; const lds_cptr vp0=shm3+LDS_V+((lane>>4)&1)*32+(lane&3)*8+(4*hi+((lane&15)>>2))*64;
  const int NT=SEQ/KVBLK;
  DMA_K(0,0);DMA_V(0,0);DMA_K(1,SLOTB);
  bf16x8 qr[4];
  #pragma unroll
  for(int d0=0;d0<4;++d0)qr[d0]=*reinterpret_cast<const bf16x8*>(&Qw[(long)r32*QP+d0*16+hi*8]);
  float mhat=0.f,l_reg=0.f;f32x16 o[2];o[0]=f32x16{};o[1]=f32x16{};f32x16 negm=f32x16{};asm volatile("":"+v"(negm));
  const int qrel=wid*QBLK+r32;
  #define CMASK(P0,P1,t) do{}while(0)
  bool resc=false;
  #define START(P0,P1) do{ const float rm=rowmax(P0,P1); resc=false; \
    { const float dl=rm; mhat=fadd_s(mhat,dl); \
      _Pragma("unroll") for(int r=0;r<16;++r){P0[r]=fsub_s(P0[r],dl);P1[r]=fsub_s(P1[r],dl);} \
      _Pragma("unroll") for(int r=0;r<16;++r)negm[r]=-mhat; asm volatile("":"+v"(negm)); } \
    _Pragma("unroll") for(int r=0;r<16;++r)P0[r]=__builtin_amdgcn_exp2f(P0[r]); }while(0)
  #define RESC() do{ if(resc){ asm volatile("s_waitcnt lgkmcnt(0)":::"memory"); \
      _Pragma("unroll") for(int d_=0;d_<2;++d_) _Pragma("unroll") for(int r=0;r<16;++r)o[d_][r]*=wsf[crow(r,hi)]; } }while(0)
  f32x16 pA0,pA1,pB0,pB1;
  int sl_prev=0,sl_cur=0,sl_next=SLOTB;
  #define ROT() do{sl_prev=sl_cur;sl_cur=sl_next;sl_next=(sl_next==(NSLOT-1)*SLOTB)?0:sl_next+SLOTB;}while(0)
  DMA_K(2,2*SLOTB);
  WAIT_BAR(3);
  qkt(pA0,pA1,Kbase,qr,negm,r32,hi);asm volatile("s_nop 15\n\ts_nop 7":"+v"(pA0),"+v"(pA1));CMASK(pA0,pA1,0);
  START(pA0,pA1);
  _Pragma("unroll") for(int r=0;r<16;++r)pA1[r]=__builtin_amdgcn_exp2f(pA1[r]);
  WAIT_BAR(0);
  DMA_K(3,0);DMA_V(1,SLOTB);
  ROT();
  kload8(kf,kp0+sl_cur);
  WAIT_BAR(2);
  s16x4 vlo[8],vhi[8]; u32x4 pw0,pw1,pw2,pw3;
  #define PKW(P,B) cvtpk_s(P[B],P[B+1])
  #define PAF(k) __builtin_bit_cast(bf16x8,pw##k)
  #define VFR(i) (bf16x8){vlo[i][0],vlo[i][1],vlo[i][2],vlo[i][3],vhi[i][0],vhi[i][1],vhi[i][2],vhi[i][3]}
  #define PIN(x) asm volatile("":"+v"(x))
  #define MX3(a,b,c) __builtin_fmaxf(__builtin_fmaxf((a),(b)),(c))
  #define GAPA(MF,A0,A1,A2,A3,W0,W1,PW) do{ MF; sacc+=A0; sacc+=A1; sacc+=A2; sacc+=A3; PIN(sacc); W0; W1; PIN(PW); SBAR(); }while(0)
  #define EX(v) __builtin_amdgcn_exp2f(v)
  #define GAPB(MF,X,B) do{ MF; X[B]=EX(X[B]); X[B+1]=EX(X[B+1]); X[B+2]=EX(X[B+2]); X[B+3]=EX(X[B+3]); PIN(X); SBAR(); }while(0)
  #define VRD(i) do{ vlo[i]=vtr(vp_+(((i)>>2)*4096+((i)&3)*1024)); vhi[i]=vtr(vp_+(((i)>>2)*4096+((i)&3)*1024+512)); }while(0)
  #define KRD(G,j) do{ if(G){ kload2(kf,kp0+sl_next,j); SBAR(); } }while(0)
  #define STEP(C0,C1,P0,P1,t,GK,GV,GL) do{ SBAR(); \
    const lds_cptr vp_=vp0+sl_prev; \
    VRD(0); SBAR(); float sacc=(P0[0]+P0[1]); \
    GAPA(C0=__builtin_amdgcn_mfma_f32_32x32x16_bf16(kf[0],qr[0],negm,0,0,0), P0[2],P0[3],P0[4],P0[5],     pw0[0]=PKW(P0,0), pw0[1]=PKW(P0,2), pw0); \
    VRD(4); SBAR(); GAPA(C1=__builtin_amdgcn_mfma_f32_32x32x16_bf16(kf[1],qr[0],negm,0,0,0), P0[6],P0[7],P0[8],P0[9],     pw0[2]=PKW(P0,4), pw0[3]=PKW(P0,6), pw0); \
    VRD(1); SBAR(); GAPA(C0=__builtin_amdgcn_mfma_f32_32x32x16_bf16(kf[2],qr[1],C0,0,0,0),   P0[10],P0[11],P0[12],P0[13], pw1[0]=PKW(P0,8), pw1[1]=PKW(P0,10), pw1); \
    VRD(5); SBAR(); GAPA(C1=__builtin_amdgcn_mfma_f32_32x32x16_bf16(kf[3],qr[1],C1,0,0,0),   P0[14],P0[15],P1[0],P1[1],   pw1[2]=PKW(P0,12),pw1[3]=PKW(P0,14), pw1); \
    VRD(2); SBAR(); GAPA(C0=__builtin_amdgcn_mfma_f32_32x32x16_bf16(kf[4],qr[2],C0,0,0,0),   P1[2],P1[3],P1[4],P1[5],     pw2[0]=PKW(P1,0), pw2[1]=PKW(P1,2), pw2); \
    VRD(6); SBAR(); GAPA(C1=__builtin_amdgcn_mfma_f32_32x32x16_bf16(kf[5],qr[2],C1,0,0,0),   P1[6],P1[7],P1[8],P1[9],     pw2[2]=PKW(P1,4), pw2[3]=PKW(P1,6), pw2); \
    VRD(3); SBAR(); GAPA(C0=__builtin_amdgcn_mfma_f32_32x32x16_bf16(kf[6],qr[3],C0,0,0,0),   P1[10],P1[11],P1[12],P1[13], pw3[0]=PKW(P1,8), pw3[1]=PKW(P1,10), pw3); \
    VRD(7); SBAR(); GAPA(C1=__builtin_amdgcn_mfma_f32_32x32x16_bf16(kf[7],qr[3],C1,0,0,0),   P1[14],P1[15],0.f,0.f,       pw3[2]=PKW(P1,12),pw3[3]=PKW(P1,14), pw3); \
    l_reg+=sacc; \
    if(GK){DMA_K((t)+3,sl_cur);} if(GV){DMA_V((t)+1,sl_next);} \
    CMASK(C0,C1,t); \
    { float a=MX3(C0[0],C0[1],C1[0]),b=MX3(C0[2],C0[3],C1[1]); a=MX3(a,C1[2],C1[3]); \
      _Pragma("unroll") for(int r=4;r<16;r+=4){a=MX3(a,C0[r],C0[r+1]);b=MX3(b,C0[r+2],C0[r+3]);a=MX3(a,C1[r],C1[r+1]);b=MX3(b,C1[r+2],C1[r+3]);} \
      float rm=__builtin_fmaxf(a,b); { auto rr=__builtin_amdgcn_permlane32_swap(__float_as_uint(rm),__float_as_uint(rm),false,false); rm=__builtin_fmaxf(__uint_as_float(rr[0]),__uint_as_float(rr[1])); } \
      resc=false; \
      if(__builtin_expect(__any(rm>(float)THRL),0)){ const float dl=__builtin_fmaxf(rm,0.f); mhat+=dl; \
        _Pragma("unroll") for(int r=0;r<16;++r){C0[r]-=dl;C1[r]-=dl;} \
        _Pragma("unroll") for(int r=0;r<16;++r)negm[r]=-mhat; asm volatile("":"+v"(negm)); \
        const float f=__builtin_amdgcn_exp2f(-dl); l_reg*=f; if(hi==0)wsf[r32]=f; resc=true; } } \
    SBAR(); \
    GAPB(o[0]=__builtin_amdgcn_mfma_f32_32x32x16_bf16(PAF(0),VFR(0),o[0],0,0,0), C0,0); \
    GAPB(o[1]=__builtin_amdgcn_mfma_f32_32x32x16_bf16(PAF(0),VFR(4),o[1],0,0,0), C0,4); \
    KRD(GL,0); GAPB(o[0]=__builtin_amdgcn_mfma_f32_32x32x16_bf16(PAF(1),VFR(1),o[0],0,0,0), C0,8); \
    KRD(GL,1); GAPB(o[1]=__builtin_amdgcn_mfma_f32_32x32x16_bf16(PAF(1),VFR(5),o[1],0,0,0), C0,12); \
    KRD(GL,2); GAPB(o[0]=__builtin_amdgcn_mfma_f32_32x32x16_bf16(PAF(2),VFR(2),o[0],0,0,0), C1,0); \
    KRD(GL,3); GAPB(o[1]=__builtin_amdgcn_mfma_f32_32x32x16_bf16(PAF(2),VFR(6),o[1],0,0,0), C1,4); \
    GAPB(o[0]=__builtin_amdgcn_mfma_f32_32x32x16_bf16(PAF(3),VFR(3),o[0],0,0,0), C1,8); \
    GAPB(o[1]=__builtin_amdgcn_mfma_f32_32x32x16_bf16(PAF(3),VFR(7),o[1],0,0,0), C1,12); \
    }while(0)
  int t=1;
  #undef CMASK
  #define CMASK(P0,P1,t) do{}while(0)
  for(;t+5<NT;t+=2){
    STEP(pB0,pB1,pA0,pA1,t,true,true,true);     WAIT_BAR(2); RESC(); ROT();
    STEP(pA0,pA1,pB0,pB1,t+1,true,true,true);   WAIT_BAR(2); RESC(); ROT();
  }
  #undef CMASK
  #define CMASK(P0,P1,t) do{}while(0)
  #define ENDW(tt) do{ if((tt)+3<NT){WAIT_BAR(2);} else if((tt)+2<NT){WAIT_BAR(1);} else {WAIT_BAR(0);} }while(0)
  for(;t+1<NT;t+=2){
    STEP(pB0,pB1,pA0,pA1,t,(t+3<NT),(t+1<NT),(t+1<NT));       ENDW(t);   RESC(); ROT();
    STEP(pA0,pA1,pB0,pB1,t+1,(t+4<NT),(t+2<NT),(t+2<NT));     ENDW(t+1); RESC(); ROT();
  }
  STEP(pB0,pB1,pA0,pA1,NT-1,false,false,false); RESC();
  { float sacc=pB0[0]+pB0[1]; _Pragma("unroll") for(int r=2;r<16;++r)sacc+=pB0[r]; _Pragma("unroll") for(int r=0;r<16;++r)sacc+=pB1[r]; l_reg+=sacc;
    pw0=(u32x4){PKW(pB0,0),PKW(pB0,2),PKW(pB0,4),PKW(pB0,6)};pw1=(u32x4){PKW(pB0,8),PKW(pB0,10),PKW(pB0,12),PKW(pB0,14)};pw2=(u32x4){PKW(pB1,0),PKW(pB1,2),PKW(pB1,4),PKW(pB1,6)};pw3=(u32x4){PKW(pB1,8),PKW(pB1,10),PKW(pB1,12),PKW(pB1,14)};
    SBAR(); pv(o,vb0+sl_cur,PAF(0),PAF(1),PAF(2),PAF(3)); }
  #undef PKW
  #undef PAF
  #undef VFR
  #undef PIN
  #undef MX3
  #undef GAPA
  #undef GAPB
  #undef EX
  #undef VRD
  #undef KRD
  #undef STEP
  #undef ENDW
  {auto rr=__builtin_amdgcn_permlane32_swap(__float_as_uint(l_reg),__float_as_uint(l_reg),false,false);l_reg=__uint_as_float(rr[0])+__uint_as_float(rr[1]);}
  if(hi==0)wsf[32+r32]=l_reg;asm volatile("s_waitcnt lgkmcnt(0)":::"memory");
  float rli[16];
  #pragma unroll
  for(int r=0;r<16;++r)rli[r]=__builtin_amdgcn_rcpf(wsf[32+crow(r,hi)]);
  bf16*Ow=O+(rowbase+q0+wid*QBLK)*OP+h*D;
  { bf16*stg=(bf16*)(shm+LDS_OST)+wid*2048;
    #pragma unroll
    for(int r=0;r<16;++r){const int orow=crow(r,hi);
      #pragma unroll
      for(int d0=0;d0<2;++d0)stg[orow*64+d0*32+r32]=__float2bfloat16(o[d0][r]*rli[r]);}
    asm volatile("s_waitcnt lgkmcnt(0)":::"memory");
    #pragma unroll
    for(int i=0;i<4;++i){const int row=i*8+(lane>>3),ch=lane&7; const u32x4 v=*(const u32x4*)(stg+row*64+ch*8); ATTN_STORE16(Ow+(long)row*OP+ch*8,v);} }
  asm volatile("s_waitcnt lgkmcnt(0)\n\ts_barrier":::"memory");
  #undef DMA_K
  #undef DMA_V
  #undef CMASK
  #undef START
  #undef RESC
  #undef ROT
}
constexpr int ATTN_LDS_BYTES=LDS_BYTES;
struct AttnTensors { const bf16* Q; const bf16* K; const bf16* V; bf16* O; };
struct AttnUnit { int bh; int qb; };
struct StaticOrder {
  int vcu, G;
  __device__ __forceinline__ explicit StaticOrder(int grid,int block):vcu((grid%8==0)?(block%8)*(grid/8)+block/8:block),G(grid){}
  __device__ __forceinline__ bool next(int i,AttnUnit&u)const{ const int per=(BATCH*NHEAD*NQB+G-1)/G; if(i>=per)return false; const int U=vcu*per+i; if(U>=BATCH*NHEAD*NQB)return false; u.bh=U/NQB; u.qb=U%NQB; return true; }
};
template<class Sched,int THRL=8> __device__ __forceinline__ void attn_phase(char*lds,const AttnTensors&T,const Sched&S){
  AttnUnit u;
  for(int i=0;S.next(i,u);++i){ attn_unit<THRL>(u.bh/NHEAD,u.bh%NHEAD,u.qb,T.Q,T.K,T.V,T.O,lds); }
}
#undef SBAR
#undef WAIT_BAR
}
#define GAS __attribute__((address_space(1)))
#define LAS __attribute__((address_space(3)))
typedef unsigned short bf16;
typedef unsigned v4u __attribute__((ext_vector_type(4)));
typedef float f32x4 __attribute__((ext_vector_type(4)));
typedef short bf16x8 __attribute__((ext_vector_type(8)));
typedef GAS unsigned gu32;
typedef GAS unsigned long long gu64;
#define RLX_AGENT __ATOMIC_RELAXED, __HIP_MEMORY_SCOPE_AGENT
#define LDS_WAIT() asm volatile("s_waitcnt lgkmcnt(0)" ::: "memory")
#define VM_WAIT() asm volatile("s_waitcnt vmcnt(0)" ::: "memory")
__device__ __forceinline__ unsigned long long rt() { return __builtin_amdgcn_s_memrealtime(); }
__device__ __forceinline__ unsigned f2bf(float f) { unsigned u = __builtin_bit_cast(unsigned, f); return (u + 0x7fffu + ((u >> 16) & 1u)) >> 16; }
__device__ __forceinline__ unsigned pk2(float lo, float hi) { return f2bf(lo) | (f2bf(hi) << 16); }

#define XB_TMO      128
#define XB_XCNT(j)  (256  + 64 * (j))
#define XB_XSUB(j)  (1280 + 64 * (j))
#define XB_XGEN(j)  (2304 + 64 * (j))
#define XB_TOP      3328
#define XB_TOPGEN   3392
#define XCD_BAR_WORDS 3456
#ifndef XB_SPIN_CAP
#define XB_SPIN_CAP (1u << 26)
#endif

__device__ __forceinline__ unsigned xb_ld(unsigned* p)              { return __hip_atomic_load(p, __ATOMIC_RELAXED, __HIP_MEMORY_SCOPE_AGENT); }
__device__ __forceinline__ unsigned xb_add(unsigned* p, unsigned v) { return __hip_atomic_fetch_add(p, v, __ATOMIC_RELAXED, __HIP_MEMORY_SCOPE_AGENT); }
__device__ __forceinline__ unsigned xb_xcc_id() { return (unsigned)__builtin_amdgcn_s_getreg((3 << 11) | 20) & 0xFu; }
#define XB_SPIN(cond, bar) do { unsigned _sp = 0; while (cond) { __builtin_amdgcn_s_sleep(1); \
    if ((++_sp & 255u) == 0u) { if (xb_ld(&(bar)[XB_TMO])) break; if (_sp > XB_SPIN_CAP) { atomicAdd(&(bar)[XB_TMO], 1u); break; } } } } while (0)

struct XcdBarrier {
    unsigned* bar; unsigned x;
    volatile LAS unsigned* st;
};

__device__ __forceinline__ XcdBarrier xcd_barrier_post(unsigned* bar, volatile LAS unsigned* st) {
    XcdBarrier b; b.bar = bar; b.x = xb_xcc_id(); b.st = st;
    if (threadIdx.x == 0) (void)xb_add(&bar[XB_XCNT(b.x)], 1u);
    return b;
}
__device__ __forceinline__ void xcd_barrier_complete(unsigned* bar, unsigned x, unsigned& nloc, unsigned& nx) {
    const unsigned G = gridDim.x * gridDim.y * gridDim.z;
    unsigned sum, cnt, mine, sp = 0u;
    for (;;) {
        sum = 0u; cnt = 0u; mine = 0u;
#pragma unroll
        for (unsigned j = 0; j < 16; ++j) { const unsigned c = xb_ld(&bar[XB_XCNT(j)]); sum += c; cnt += (c > 0u) ? 1u : 0u; mine = (j == x) ? c : mine; }
        if (sum == G) break;
        __builtin_amdgcn_s_sleep(1);
        if ((++sp & 255u) == 0u) { if (xb_ld(&bar[XB_TMO])) break; if (sp > XB_SPIN_CAP) { atomicAdd(&bar[XB_TMO], 1u); break; } }
    }
    nloc = mine > 0u ? mine : 1u; nx = cnt > 0u ? cnt : 1u;
}

__device__ __forceinline__ void xcd_barrier(const XcdBarrier& b) {
    asm volatile("s_waitcnt vmcnt(0)" ::: "memory");
    __syncthreads();
    if (threadIdx.x == 0) {
        unsigned* bar = b.bar;
        __builtin_amdgcn_s_waitcnt(0);
        unsigned nloc = b.st[0], nx = b.st[1];
        if (nloc == 0u) { xcd_barrier_complete(bar, b.x, nloc, nx); b.st[0] = nloc; b.st[1] = nx; }
        const unsigned old = xb_add(&bar[XB_XSUB(b.x)], 1u);
        const unsigned gen = old / nloc;
        if (old + 1u == (gen + 1u) * nloc) {
            __builtin_amdgcn_fence(__ATOMIC_RELEASE, "agent");
            asm volatile("s_waitcnt vmcnt(0)" ::: "memory");
            const unsigned og = xb_add(&bar[XB_TOP], 1u);
            const unsigned tg = og / nx;
            if (og + 1u == (tg + 1u) * nx) xb_add(&bar[XB_TOPGEN], 1u);
            else XB_SPIN(xb_ld(&bar[XB_TOPGEN]) == tg, bar);
            __builtin_amdgcn_fence(__ATOMIC_ACQUIRE, "agent");
            xb_add(&bar[XB_XGEN(b.x)], 1u);
            asm volatile("s_waitcnt vmcnt(0)" ::: "memory");
        } else {
            XB_SPIN(xb_ld(&bar[XB_XGEN(b.x)]) == gen, bar);
            __builtin_amdgcn_fence(__ATOMIC_ACQUIRE, "agent");
            asm volatile("s_waitcnt vmcnt(0)" ::: "memory");
        }
    }
    __syncthreads();
}
struct Args { const float* in[18]; float* out; unsigned char* ws; int ph_lo, ph_hi; };
enum { I_X = 0, I_C, I_WADA, I_BADA, I_NMG, I_WIN, I_QG, I_KG, I_CONVW, I_CONVB, I_GATEB, I_MNG, I_WOUT, I_NFG, I_WGATE, I_WUP, I_WDOWN, I_FNG };

__device__ __forceinline__ float wave_sum(float v) {
#pragma unroll
    for (int o = 1; o < 64; o <<= 1) v += __shfl_xor(v, o);
    return v;
}
__device__ __forceinline__ float bf2f(bf16 h) { return __builtin_bit_cast(float, (unsigned)h << 16); }
__device__ __forceinline__ float bflo(unsigned w) { return __builtin_bit_cast(float, w << 16); }
__device__ __forceinline__ float bfhi(unsigned w) { return __builtin_bit_cast(float, w & 0xffff0000u); }

__device__ __forceinline__ int colmap_in(int j) {
    const int pn = j >> 8, jj = j & 255, bj = jj >> 7, wc = (jj >> 5) & 3, n = (jj >> 4) & 1, fq = (jj >> 2) & 3, e = jj & 3;
    return (pn <= 2) ? 256 * pn + 64 * wc + 16 * (2 * bj + n) + 4 * fq + e : 256 * pn + 128 * bj + 32 * wc + 8 * fq + 4 * n + e;
}
__device__ __forceinline__ int colmap_gu(int j) {
    const int pn = j >> 8, jj = j & 255, wc = (jj >> 5) & 3, n = (jj >> 4) & 1, fq = (jj >> 2) & 3, e = jj & 3;
    return 128 * pn + 32 * wc + 8 * fq + 4 * n + e;
}
__device__ __forceinline__ void transpose_item(const float* W, int ldw, int K, bf16* WT, int n0, int k0, int srccol, LAS float* scr, int lane) {
#pragma unroll 8
    for (int i = 0; i < 32; ++i) { const int kk = 2 * i + (lane >> 5); scr[kk * 33 + (lane & 31)] = W[(size_t)(k0 + kk) * ldw + srccol]; }
    LDS_WAIT(); asm volatile("" ::: "memory");
    const int c = lane & 7;
#pragma unroll
    for (int j = 0; j < 4; ++j) { const int n = (lane >> 3) + 8 * j; const LAS float* s = scr + (8 * c) * 33 + n;
        v4u o; o.x = pk2(s[0 * 33], s[1 * 33]); o.y = pk2(s[2 * 33], s[3 * 33]); o.z = pk2(s[4 * 33], s[5 * 33]); o.w = pk2(s[6 * 33], s[7 * 33]);
        *(GAS v4u*)(WT + (size_t)(n0 + n) * K + k0 + 8 * c) = o; }
    LDS_WAIT(); asm volatile("" ::: "memory");
}

__device__ __forceinline__ void p0_prologue(const Args& A, LAS unsigned char* lds, int tid, int lane, int wave, int vcu, int G) {
    unsigned char* ws = A.ws;
    LAS float* sc = (LAS float*)(lds + 73728);
    for (int i = tid; i < 8192; i += NTHREADS) { const int b = i >> 10, k = i & 1023; const float cv = A.in[I_C][i]; sc[k * 8 + b] = cv / (1.0f + expf(-cv)); }
    __syncthreads();
    LAS float* scr = (LAS float*)(lds + wave * 9216);
    const int gw = vcu * NWAVES + wave, NGW = G * NWAVES;
    constexpr int I_MOD = 96 * 8, T_IN = 16 * 88, T_OUT = 16 * 32, T_GU = 16 * 176, T_DN = 44 * 32;
    constexpr int NITEMS = I_MOD + T_IN + T_OUT + T_GU + T_DN;
    float* mod = (float*)(ws + WS_MOD);
    for (int it = gw; it < NITEMS; it += NGW) {
        int r = it;
        if (r < I_MOD) {
            const int cg = r >> 3, ks = r & 7, col = cg * 64 + lane; const float* w = A.in[I_WADA] + (size_t)(ks * 128) * NMOD + col;
            float acc[8];
#pragma unroll
            for (int b = 0; b < 8; ++b) acc[b] = 0.f;
#pragma unroll 8
            for (int kk = 0; kk < 128; ++kk) { const float wv = w[(size_t)kk * NMOD]; const f32x4 s0 = *(const LAS f32x4*)(sc + (ks * 128 + kk) * 8), s1 = *(const LAS f32x4*)(sc + (ks * 128 + kk) * 8 + 4);
                acc[0] += s0[0] * wv; acc[1] += s0[1] * wv; acc[2] += s0[2] * wv; acc[3] += s0[3] * wv; acc[4] += s1[0] * wv; acc[5] += s1[1] * wv; acc[6] += s1[2] * wv; acc[7] += s1[3] * wv; }
            const float bias = (ks == 0) ? A.in[I_BADA][col] : 0.f;
#pragma unroll
            for (int b = 0; b < 8; ++b) atomicAdd(mod + b * NMOD + col, acc[b] + bias);
            continue;
        }
        r -= I_MOD;
        if (r < T_IN) { const int kb = r / 88, nb = r % 88; transpose_item(A.in[I_WIN], NIN, DMODEL, (bf16*)(ws + WS_WIN), 32 * nb, 64 * kb, colmap_in(32 * nb + (lane & 31)), scr, lane); continue; }
        r -= T_IN;
        if (r < T_OUT) { const int kb = r / 32, nb = r % 32; transpose_item(A.in[I_WOUT], DMODEL, DMODEL, (bf16*)(ws + WS_WO), 32 * nb, 64 * kb, 32 * nb + (lane & 31), scr, lane); continue; }
        r -= T_OUT;
        if (r < T_GU) { const int kb = r / 176, nb = r % 176; const int j0 = 32 * nb; const float* W = ((j0 >> 7) & 1) ? A.in[I_WUP] : A.in[I_WGATE];
            transpose_item(W, FFH, DMODEL, (bf16*)(ws + WS_WGU), j0, 64 * kb, colmap_gu(j0 + (lane & 31)), scr, lane); continue; }
        r -= T_GU;
        { const int kb = r / 32, nb = r % 32; transpose_item(A.in[I_WDOWN], DMODEL, FFH, (bf16*)(ws + WS_WD), 32 * nb, 64 * kb, 32 * nb + (lane & 31), scr, lane); }
    }
    if (blockIdx.x == 0) {
        for (int i = tid; i < 1024; i += NTHREADS) { const int pos = i >> 4, f = i & 15; const float inv = powf(10000.0f, -(float)(2 * f) / 32.0f); const float ang = (float)pos * inv;
            ((float*)(ws + WS_TABC))[i] = cosf(ang); ((float*)(ws + WS_TABS))[i] = sinf(ang); }
        if (tid < 128) ((float*)(ws + WS_QKG))[tid] = (tid < 64) ? A.in[I_QG][tid] : A.in[I_KG][tid - 64];
    }
    if (blockIdx.x == 1 % G) {
        for (int i = tid; i < 16 * 1024; i += NTHREADS) { const int gi = i >> 10, k = i & 1023; ((bf16*)(ws + WS_WGT))[i] = (bf16)f2bf(A.in[I_WIN][(size_t)k * NIN + NPROJ + gi]); }
    }
}

template <int MODE> __device__ __forceinline__ void row_pass(const Args& A, int lane, int gw, int NGW) {
    const float* src = (MODE == 0) ? A.in[I_X] : A.out; const float* g = (MODE == 0) ? A.in[I_NMG] : (MODE == 1) ? A.in[I_NFG] : A.in[I_FNG];
    const float* mod = (const float*)(A.ws + WS_MOD); bf16* XN = (bf16*)(A.ws + WS_XN);
    for (int rg = gw; rg < M / 16; rg += NGW) {
        const int b = (rg * 16) >> 12; f32x4 gp[4], sh[4];
#pragma unroll
        for (int j = 0; j < 4; ++j) { const int col = 4 * lane + 256 * j; gp[j] = *(const f32x4*)(g + col);
            if (MODE < 2) { const int o = (MODE == 0) ? 0 : 3072; const f32x4 s = *(const f32x4*)(mod + b * NMOD + o + 1024 + col); gp[j] = gp[j] * (s + 1.0f); sh[j] = *(const f32x4*)(mod + b * NMOD + o + col); } }
        for (int i = 0; i < 16; ++i) {
            const size_t row = (size_t)rg * 16 + i; const f32x4* xr = (const f32x4*)(src + row * DMODEL) + lane;
            f32x4 v[4]; float s = 0.f;
#pragma unroll
            for (int j = 0; j < 4; ++j) { v[j] = xr[64 * j]; s += (v[j][0] * v[j][0] + v[j][1] * v[j][1]) + (v[j][2] * v[j][2] + v[j][3] * v[j][3]); }
            const float rstd = 1.0f / sqrtf(wave_sum(s) * (1.0f / DMODEL) + EPS);
            if (MODE < 2) {
                unsigned long long* o8 = (unsigned long long*)(XN + row * DMODEL) + lane;
#pragma unroll
                for (int j = 0; j < 4; ++j) { const f32x4 y = v[j] * rstd * gp[j] + sh[j]; o8[64 * j] = (unsigned long long)pk2(y[0], y[1]) | ((unsigned long long)pk2(y[2], y[3]) << 32); }
            } else {
                f32x4* o = (f32x4*)(A.out + row * DMODEL) + lane;
#pragma unroll
                for (int j = 0; j < 4; ++j) o[64 * j] = v[j] * rstd * gp[j];
            }
        }
    }
}
__device__ __forceinline__ void gates_pass(const Args& A, int lane, int gw, int NGW) {
    const bf16* XN = (const bf16*)(A.ws + WS_XN); const bf16* WgT = (const bf16*)(A.ws + WS_WGT); float* GT = (float*)(A.ws + WS_GATES);
    const int fr = lane & 15, fq = lane >> 4; const f32x4 gb = *(const f32x4*)(A.in[I_GATEB] + 4 * fq);
    for (int rg = gw; rg < M / 16; rg += NGW) {
        f32x4 acc = {0.f, 0.f, 0.f, 0.f}; const bf16* ap = XN + ((size_t)rg * 16 + fr) * DMODEL + 8 * fq; const bf16* bp = WgT + (size_t)fr * DMODEL + 8 * fq;
#pragma unroll 4
        for (int k0 = 0; k0 < DMODEL; k0 += 32) acc = __builtin_amdgcn_mfma_f32_16x16x32_bf16(*(const bf16x8*)(bp + k0), *(const bf16x8*)(ap + k0), acc, 0, 0, 0);
        *(f32x4*)(GT + ((size_t)rg * 16 + fr) * 16 + 4 * fq) = acc + gb;
    }
}
__device__ __forceinline__ void attn_naive_item(const bf16* Q, const bf16* K, const bf16* V, bf16* Y, int item, int tid) {
    const int b = item >> 6, h = (item >> 3) & 7, seg = item & 7, kvh = h >> 2;
    const size_t row = (size_t)b * SEQ + seg * 512 + tid;
    float q[64], o[64];
    { const v4u* qp = (const v4u*)(Q + row * 512 + h * 64);
#pragma unroll
      for (int i = 0; i < 8; ++i) { const v4u w = qp[i]; q[8 * i] = bflo(w.x); q[8 * i + 1] = bfhi(w.x); q[8 * i + 2] = bflo(w.y); q[8 * i + 3] = bfhi(w.y); q[8 * i + 4] = bflo(w.z); q[8 * i + 5] = bfhi(w.z); q[8 * i + 6] = bflo(w.w); q[8 * i + 7] = bfhi(w.w); } }
#pragma unroll
    for (int d = 0; d < 64; ++d) o[d] = 0.f;
    float m = -1e30f, l = 0.f;
    int z = 0; asm volatile("" : "+v"(z));
    const bf16* Kp = K + (size_t)b * SEQ * 128 + kvh * 64 + z; const bf16* Vp = V + (size_t)b * SEQ * 128 + kvh * 64 + z;
    for (int s = 0; s < SEQ; ++s) {
        const v4u* kr = (const v4u*)(Kp + (size_t)s * 128); float dot = 0.f;
#pragma unroll
        for (int i = 0; i < 8; ++i) { const v4u w = kr[i]; dot += q[8 * i] * bflo(w.x) + q[8 * i + 1] * bfhi(w.x) + q[8 * i + 2] * bflo(w.y) + q[8 * i + 3] * bfhi(w.y) + q[8 * i + 4] * bflo(w.z) + q[8 * i + 5] * bfhi(w.z) + q[8 * i + 6] * bflo(w.w) + q[8 * i + 7] * bfhi(w.w); }
        const float mn = fmaxf(m, dot), corr = exp2f(m - mn), p = exp2f(dot - mn); l = l * corr + p; m = mn;
        const v4u* vr = (const v4u*)(Vp + (size_t)s * 128);
#pragma unroll
        for (int i = 0; i < 8; ++i) { const v4u w = vr[i];
            o[8 * i] = o[8 * i] * corr + p * bflo(w.x); o[8 * i + 1] = o[8 * i + 1] * corr + p * bfhi(w.x); o[8 * i + 2] = o[8 * i + 2] * corr + p * bflo(w.y); o[8 * i + 3] = o[8 * i + 3] * corr + p * bfhi(w.y);
            o[8 * i + 4] = o[8 * i + 4] * corr + p * bflo(w.z); o[8 * i + 5] = o[8 * i + 5] * corr + p * bfhi(w.z); o[8 * i + 6] = o[8 * i + 6] * corr + p * bflo(w.w); o[8 * i + 7] = o[8 * i + 7] * corr + p * bfhi(w.w); }
    }
    const float inv = 1.0f / l; v4u* yp = (v4u*)(Y + row * 1024 + h * 64);
#pragma unroll
    for (int i = 0; i < 8; ++i) { v4u w; w.x = pk2(o[8 * i] * inv, o[8 * i + 1] * inv); w.y = pk2(o[8 * i + 2] * inv, o[8 * i + 3] * inv); w.z = pk2(o[8 * i + 4] * inv, o[8 * i + 5] * inv); w.w = pk2(o[8 * i + 6] * inv, o[8 * i + 7] * inv); yp[i] = w; }
}
__device__ __forceinline__ void mlstm_naive_item(const Args& A, int item, LAS float* lds, int tid) {
    const int b = item >> 3, h = (item >> 1) & 3, dir = item & 1, v = tid >> 2, dq = tid & 3;
    const bf16* QKM = (const bf16*)(A.ws + WS_QKM); const bf16* VM = (const bf16*)(A.ws + WS_VM); const float* GT = (const float*)(A.ws + WS_GATES);
    float* HF = (float*)(A.ws + WS_HF) + (size_t)dir * M * 512; const float* cw = A.in[I_CONVW]; const float* cb = A.in[I_CONVB];
    LAS float* qs = lds; LAS float* ks = lds + 32 * 128; LAS float* vs = lds + 2 * 32 * 128; LAS float* gi = lds + 3 * 32 * 128; LAS float* gf = gi + 32;
    float C[32], n[32]; float m = 0.f;
#pragma unroll
    for (int i = 0; i < 32; ++i) { C[i] = 0.f; n[i] = 0.f; }
    for (int blk = 0; blk < SEQ / 32; ++blk) {
        for (int idx = tid; idx < 32 * 256; idx += NTHREADS) { const int tt = idx >> 8, c = idx & 255, p = blk * 32 + tt, pos = dir ? SEQ - 1 - p : p;
            const int ch = (c < 128) ? h * 128 + c : 512 + h * 128 + (c - 128); float a = cb[ch];
#pragma unroll
            for (int j = 0; j < 5; ++j) { const int pp = pos - 2 + j; if (pp >= 0 && pp < SEQ) a += cw[j * 1024 + ch] * bf2f(QKM[((size_t)b * SEQ + pp) * 1024 + ch]); }
            const float sv = a / (1.0f + expf(-a));
            if (c < 128) qs[tt * 128 + c] = sv; else ks[tt * 128 + c - 128] = sv * 0.08838834764831845f; }
        for (int idx = tid; idx < 32 * 128; idx += NTHREADS) { const int tt = idx >> 7, c = idx & 127, p = blk * 32 + tt, pos = dir ? SEQ - 1 - p : p; vs[tt * 128 + c] = bf2f(VM[((size_t)b * SEQ + pos) * 512 + h * 128 + c]); }
        if (tid < 32) { const int p = blk * 32 + tid, pos = dir ? SEQ - 1 - p : p; const float* gp = GT + ((size_t)b * SEQ + pos) * 16; gi[tid] = gp[dir * 8 + h]; const float f = gp[dir * 8 + 4 + h]; gf[tid] = fminf(f, 0.f) - log1pf(expf(-fabsf(f))); }
        __syncthreads();
        for (int tt = 0; tt < 32; ++tt) {
            const float it = gi[tt], lf = gf[tt], mn = fmaxf(lf + m, it), fg = expf(lf + m - mn), ig = expf(it - mn); m = mn;
            const float vv = vs[tt * 128 + v] * ig; float num = 0.f, den = 0.f;
#pragma unroll
            for (int i4 = 0; i4 < 8; ++i4) { const f32x4 kd = *(const LAS f32x4*)(ks + tt * 128 + dq * 32 + 4 * i4), qd = *(const LAS f32x4*)(qs + tt * 128 + dq * 32 + 4 * i4);
#pragma unroll
                for (int e = 0; e < 4; ++e) { const int i = 4 * i4 + e; C[i] = fg * C[i] + vv * kd[e]; n[i] = fg * n[i] + ig * kd[e]; num += C[i] * qd[e]; den += n[i] * qd[e]; } }
            num += __shfl_xor(num, 1); num += __shfl_xor(num, 2); den += __shfl_xor(den, 1); den += __shfl_xor(den, 2);
            if (dq == 0) { const int p = blk * 32 + tt, pos = dir ? SEQ - 1 - p : p; HF[((size_t)b * SEQ + pos) * 512 + h * 128 + v] = num / fmaxf(fabsf(den), expf(-mn)); }
        }
        __syncthreads();
    }
}
__device__ __forceinline__ void finalize_pass(const Args& A, int lane, int gw, int NGW) {
    const float* H0 = (const float*)(A.ws + WS_HF); const float* H1 = H0 + (size_t)M * 512; const bf16* OM = (const bf16*)(A.ws + WS_OM); bf16* Y = (bf16*)(A.ws + WS_Y);
    const f32x4 g0 = *(const f32x4*)(A.in[I_MNG] + 8 * lane), g1 = *(const f32x4*)(A.in[I_MNG] + 8 * lane + 4);
    for (int row = gw; row < M; row += NGW) {
        const f32x4 a0 = *(const f32x4*)(H0 + (size_t)row * 512 + 8 * lane), a1 = *(const f32x4*)(H0 + (size_t)row * 512 + 8 * lane + 4);
        const f32x4 b0 = *(const f32x4*)(H1 + (size_t)row * 512 + 8 * lane), b1 = *(const f32x4*)(H1 + (size_t)row * 512 + 8 * lane + 4);
        const f32x4 h0 = a0 + b0, h1 = a1 + b1;
        float ss = (h0[0] * h0[0] + h0[1] * h0[1]) + (h0[2] * h0[2] + h0[3] * h0[3]) + (h1[0] * h1[0] + h1[1] * h1[1]) + (h1[2] * h1[2] + h1[3] * h1[3]);
        ss += __shfl_xor(ss, 1); ss += __shfl_xor(ss, 2); ss += __shfl_xor(ss, 4); ss += __shfl_xor(ss, 8);
        const float rstd = 1.0f / sqrtf(ss * (1.0f / 128.0f) + EPS);
        const v4u ow = *(const v4u*)(OM + (size_t)row * 512 + 8 * lane);
        const float og[8] = {bflo(ow.x), bfhi(ow.x), bflo(ow.y), bfhi(ow.y), bflo(ow.z), bfhi(ow.z), bflo(ow.w), bfhi(ow.w)};
        float y[8];
#pragma unroll
        for (int e = 0; e < 4; ++e) { y[e] = h0[e] * rstd * g0[e] / (1.0f + expf(-og[e])); y[4 + e] = h1[e] * rstd * g1[e] / (1.0f + expf(-og[4 + e])); }
        v4u w; w.x = pk2(y[0], y[1]); w.y = pk2(y[2], y[3]); w.z = pk2(y[4], y[5]); w.w = pk2(y[6], y[7]);
        *(v4u*)(Y + (size_t)row * 1024 + 512 + 8 * lane) = w;
    }
}

__global__ void __launch_bounds__(NTHREADS, 2) hymba_fwd(Args args) {
    extern __shared__ __attribute__((aligned(16))) unsigned char lds_raw[];
    LAS unsigned char* lds = (LAS unsigned char*)lds_raw;
    volatile LAS unsigned* MISC = (volatile LAS unsigned*)(lds + MISC_OFF);
    const int tid = threadIdx.x, lane = tid & 63, wave = __builtin_amdgcn_readfirstlane(tid >> 6);
    const int G = gridDim.x, bx = blockIdx.x, vcu = (G % 8 == 0) ? (bx % 8) * (G / 8) + bx / 8 : bx;
    const int gw = vcu * NWAVES + wave, NGW = G * NWAVES;
    unsigned char* ws = args.ws; gu32* ctl = (gu32*)(ws + WS_CTL);
    for (int u = tid; u < (LDS_BYTES - LDSCTL_OFF) / 4; u += NTHREADS) ((LAS unsigned*)(lds + LDSCTL_OFF))[u] = 0u;
    __syncthreads();
    XcdBarrier bar; bar.bar = (unsigned*)(ctl + CW_BAR); bar.x = 0; bar.st = nullptr;
    if (N_LAUNCHES == 1) bar = xcd_barrier_post((unsigned*)(ctl + CW_BAR), MISC + 8);
#define GRID_BAR() do { if (N_LAUNCHES == 1) xcd_barrier(bar); } while (0)
    const int lo = args.ph_lo, hi = args.ph_hi;
#define IN(k) (lo <= (k) && (k) < hi)
#define BOTH(k) (IN(k) && IN((k) + 1))
    bf16* XN = (bf16*)(ws + WS_XN); float* mod = (float*)(ws + WS_MOD);

    if (IN(0)) { p0_prologue(args, lds, tid, lane, wave, vcu, G); if (BOTH(0)) GRID_BAR(); }
    if (IN(1)) { row_pass<0>(args, lane, gw, NGW); if (BOTH(1)) GRID_BAR(); }
    if (IN(2)) {
        gates_pass(args, lane, gw, NGW);
        pg8::Gemm g{XN, (const bf16*)(ws + WS_WIN), M, NPROJ, DMODEL}; pg8::StaticOrder S; S.init(M, NPROJ, G, bx);
        pg8::EpiInProj E{ws};
#if NAIVE_GEMM
        pg8::gemm_simple<pg8::EpiInProj, pg8::StaticOrder>(g, S, E);
#else
        pg8::gemm_phase<pg8::EpiInProj, pg8::StaticOrder, PG8_ALIGN, PG8_SP2>(lds, g, S, E);
#endif
        if (BOTH(2)) GRID_BAR();
    }
    if (IN(3)) {
        for (int it = bx; it < 64; it += G) mlstm_naive_item(args, it, (LAS float*)lds, tid);
#if NAIVE_ATTN
        for (int it = bx; it < 512; it += G) attn_naive_item((const bf16*)(ws + WS_Q), (const bf16*)(ws + WS_K), (const bf16*)(ws + WS_V), (bf16*)(ws + WS_Y), it, tid);
#else
        { const attn_body::AttnTensors AT{(const attn_body::bf16*)(ws + WS_Q), (const attn_body::bf16*)(ws + WS_K), (const attn_body::bf16*)(ws + WS_V), (attn_body::bf16*)(ws + WS_Y)};
          const attn_body::StaticOrder S(G, bx); attn_body::attn_phase<attn_body::StaticOrder>((char*)lds_raw, AT, S); }
#endif
        if (BOTH(3)) GRID_BAR();
    }
    if (IN(4)) { finalize_pass(args, lane, gw, NGW); if (BOTH(4)) GRID_BAR(); }
    if (IN(5)) {
        pg8::Gemm g{(const bf16*)(ws + WS_Y), (const bf16*)(ws + WS_WO), M, DMODEL, DMODEL}; pg8::StaticOrder S; S.init(M, DMODEL, G, bx);
        pg8::EpiResGate E{args.in[I_X], args.out, mod + 2048};
#if NAIVE_GEMM
        pg8::gemm_simple<pg8::EpiResGate, pg8::StaticOrder>(g, S, E);
#else
        pg8::gemm_phase<pg8::EpiResGate, pg8::StaticOrder, PG8_ALIGN, PG8_SP2>(lds, g, S, E);
#endif
        if (BOTH(5)) GRID_BAR();
    }
    if (IN(6)) { row_pass<1>(args, lane, gw, NGW); if (BOTH(6)) GRID_BAR(); }
    if (IN(7)) {
        pg8::Gemm g{XN, (const bf16*)(ws + WS_WGU), M, 2 * FFH, DMODEL}; pg8::StaticOrder S; S.init(M, 2 * FFH, G, bx);
        pg8::EpiSwiGLU E{(bf16*)(ws + WS_ACT)};
#if NAIVE_GEMM
        pg8::gemm_simple<pg8::EpiSwiGLU, pg8::StaticOrder>(g, S, E);
#else
        pg8::gemm_phase<pg8::EpiSwiGLU, pg8::StaticOrder, PG8_ALIGN, PG8_SP2>(lds, g, S, E);
#endif
        if (BOTH(7)) GRID_BAR();
    }
    if (IN(8)) {
        pg8::Gemm g{(const bf16*)(ws + WS_ACT), (const bf16*)(ws + WS_WD), M, DMODEL, FFH}; pg8::StaticOrder S; S.init(M, DMODEL, G, bx);
        pg8::EpiResGate E{args.out, args.out, mod + 5120};
#if NAIVE_GEMM
        pg8::gemm_simple<pg8::EpiResGate, pg8::StaticOrder>(g, S, E);
#else
        pg8::gemm_phase<pg8::EpiResGate, pg8::StaticOrder, PG8_ALIGN, PG8_SP2>(lds, g, S, E);
#endif
        if (BOTH(8)) GRID_BAR();
    }
    if (IN(9)) { row_pass<2>(args, lane, gw, NGW); }
#undef IN
#undef BOTH
}

extern "C" void kernel_launch(void* const* d_in, const int* in_sizes, int n_in, void* d_out, int out_size, void* d_ws, size_t ws_size, hipStream_t stream) {
    static int grid = 0;
    if (grid == 0) {
        if (n_in != 18 || in_sizes[0] != M * DMODEL || out_size != M * DMODEL || ws_size < WS_END) { fprintf(stderr, "kernel_launch: unexpected shapes (n_in %d, in0 %d, out %d, ws %zu < %zu)\n", n_in, n_in > 0 ? in_sizes[0] : -1, out_size, ws_size, (size_t)WS_END); grid = -1; return; }
        int dev = 0, cus = 0, per_cu = 0;
        if (hipGetDevice(&dev) != hipSuccess || hipDeviceGetAttribute(&cus, hipDeviceAttributeMultiprocessorCount, dev) != hipSuccess) { grid = -1; return; }
        if (hipFuncSetAttribute((const void*)hymba_fwd, hipFuncAttributeMaxDynamicSharedMemorySize, LDS_BYTES) != hipSuccess) { fprintf(stderr, "kernel_launch: hipFuncSetAttribute failed\n"); grid = -1; return; }
        if (hipOccupancyMaxActiveBlocksPerMultiprocessor(&per_cu, (const void*)hymba_fwd, NTHREADS, LDS_BYTES) != hipSuccess || per_cu < 1) { fprintf(stderr, "kernel_launch: occupancy query says %d blocks per CU\n", per_cu); (void)hipGetLastError(); grid = -1; return; }
        grid = cus;
    }
    if (grid < 0) return;
    if (hipMemsetAsync((char*)d_ws + WS_CTL, 0, CTL_ZERO_BYTES, stream) != hipSuccess) return;
    Args a{};
    for (int i = 0; i < 18; ++i) a.in[i] = (const float*)d_in[i];
    a.out = (float*)d_out; a.ws = (unsigned char*)d_ws;
    if (N_LAUNCHES == 1) { a.ph_lo = 0; a.ph_hi = NPHASE; hipLaunchKernelGGL(hymba_fwd, dim3(grid), dim3(NTHREADS), LDS_BYTES, stream, a); }
    else for (int p = 0; p < NPHASE; ++p) { a.ph_lo = p; a.ph_hi = p + 1; hipLaunchKernelGGL(hymba_fwd, dim3(grid), dim3(NTHREADS), LDS_BYTES, stream, a); }
}
```

```cpp
#include <hip/hip_runtime.h>
#include <hip/hip_bf16.h>
#include <cstdio>
#include <cstdint>
#include <cmath>
#ifndef NAIVE_GEMM
#define NAIVE_GEMM 0
#endif
#ifndef NAIVE_ATTN
#define NAIVE_ATTN 0
#endif
#ifndef MK_N_LAUNCHES
#define MK_N_LAUNCHES 1
#endif
constexpr int NWAVES = 8, NTHREADS = NWAVES * 64;
constexpr int BATCH = 8, SEQ = 4096, DMODEL = 1024, M = BATCH * SEQ;
constexpr int NPROJ = 2816, NIN = 2832, FFH = 2816, NMOD = 6144;
constexpr float EPS = 1e-6f;
constexpr int N_LAUNCHES = MK_N_LAUNCHES;
constexpr int NPHASE = 10;
constexpr size_t MiB = 1u << 20;
constexpr size_t WS_CTL = 0, CTL_ZERO_BYTES = 1 * MiB;
constexpr int CW_TMO = 0, CW_CODE = 1, CW_BAR = 4096, CW_QUEUE = 8192;
constexpr size_t WS_MOD = 512 * 1024;
constexpr size_t WS_TABC = 1 * MiB, WS_TABS = 1 * MiB + 4096, WS_QKG = 1 * MiB + 8192, WS_WGT = 1 * MiB + 65536;
constexpr size_t WS_WIN = 2 * MiB, WS_WO = 8 * MiB, WS_WGU = 10 * MiB, WS_WD = 22 * MiB;
constexpr size_t WS_XN = 32 * MiB, WS_Q = 96 * MiB, WS_K = 128 * MiB, WS_V = 136 * MiB, WS_QKM = 144 * MiB, WS_VM = 208 * MiB, WS_OM = 240 * MiB;
constexpr size_t WS_GATES = 272 * MiB, WS_Y = 276 * MiB, WS_HF = 340 * MiB, WS_END = 468 * MiB;
constexpr size_t WS_ACT = 96 * MiB;
static_assert(WS_ACT + (size_t)M * FFH * 2 <= WS_GATES, "ACT overlay");
constexpr int RING_BYTES = 131072, LDSCTL_OFF = RING_BYTES, MISC_OFF = LDSCTL_OFF + 320, LDS_BYTES = 147456;
#ifdef XB_SPIN_CAP
#undef XB_SPIN_CAP
#endif
#define XB_SPIN_CAP (1u << 26)

namespace pg8 {
#define PG8_LAS __attribute__((address_space(3)))
typedef unsigned short bf16_t;
typedef short bf16x8 __attribute__((ext_vector_type(8)));
typedef float f32x4 __attribute__((ext_vector_type(4)));
typedef unsigned u32x4 __attribute__((ext_vector_type(4)));
constexpr int BM = 256, BK = 64, HALF = 128, HTB = HALF * BK * 2  , STAGE_BYTES = 8 * HTB, NXCD = 8, WGM = 8;

__host__ __device__ __forceinline__ int lds_byte(int r, int c) { const int st = (r >> 4) * 2 + (c >> 5), rr = r & 15, cc = c & 31, ob = rr * 64 + cc * 2; return st * 1024 + (ob ^ (((ob >> 9) & 1) << 5)); }
__host__ __device__ __forceinline__ void stage_rc(int b, int& R, int& C) { const int st = b / 1024, sb = b % 1024, swz = sb ^ (((sb >> 9) & 1) << 5); R = (st >> 1) * 16 + swz / 64; C = (st & 1) * 32 + (swz % 64) / 2; }
__host__ __device__ __forceinline__ int perm32(int rho) { const int n = rho >> 4, i = rho & 15; return 8 * (i >> 2) + 4 * n + (i & 3); }

struct Unit { int pm, pn; };
struct Gemm { const bf16_t* A; const bf16_t* Bt; int M, N, K; };

struct StaticOrder {
    int nM, nN, nwg, G, c;
    __host__ __device__ void init(int M, int N, int G_, int c_) { nM = M / BM; nN = N / BM; nwg = nM * nN; G = G_; c = c_; }
    __host__ __device__ bool next(int i, Unit& u) const {
        const long L = (long)i * G + c; if (L >= nwg) return false;
        int wgid = (int)L; { const int q = nwg / NXCD, r = nwg % NXCD, xcd = wgid % NXCD, off = wgid / NXCD; wgid = (xcd < r ? xcd * (q + 1) : r * (q + 1) + (xcd - r) * q) + off; }
        const int nig = WGM * nN, gid = wgid / nig, fm = gid * WGM, gsz = (nM - fm) < WGM ? (nM - fm) : WGM;
        u.pm = fm + ((wgid % nig) % gsz); u.pn = (wgid % nig) / gsz; return true;
    }
    __device__ __forceinline__ void a_ready(const Unit&) const {}
    __device__ __forceinline__ void done(const Unit&) const {}
};

__device__ __forceinline__ unsigned cvt_pk_bf16(float lo, float hi) { unsigned r; asm volatile("v_cvt_pk_bf16_f32 %0, %1, %2" : "=v"(r) : "v"(lo), "v"(hi)); return r; }
typedef float f32x2 __attribute__((ext_vector_type(2)));
template <class Epi, class Sched, bool ALIGN_EPI = false, bool SP2 = false>
__device__ __forceinline__ void gemm_phase(PG8_LAS unsigned char* lds, const Gemm g, const Sched& S, const Epi& E) {
    const int tid = threadIdx.x, wid = __builtin_amdgcn_readfirstlane(tid >> 6), lane = tid & 63, wr = wid >> 2, wc = wid & 3, fr = lane & 15, fq = lane >> 4;
    const int K = g.K, nt = K / BK;
    unsigned voffA[2], voffB[2];
#pragma unroll
    for (int i = 0; i < 2; ++i) { int R, C; stage_rc(tid * 16 + i * 8192, R, C); const int Rb = Epi::PERM ? ((R & ~31) + perm32(R & 31)) : R;
        voffA[i] = (unsigned)(R * K + C) * 2u; voffB[i] = (unsigned)(Rb * K + C) * 2u; }
    const size_t kstep = (size_t)(BK * 2);
    const size_t hstep = (size_t)HALF * K * 2;
    const size_t tstep = 2 * hstep;
    const unsigned ldsw = (unsigned)wid * 1024u;
    const int aoff = lds_byte(wr * 64 + fr, fq * 8), boff = lds_byte(wc * 32 + fr, fq * 8);
#define PG8_SA(b, h) (((b) * 2 + (h)) * HTB)
#define PG8_SB(b, h) ((4 + (b) * 2 + (h)) * HTB)
#define PG8_STAGE(bufoff, gbase, voff) do { _Pragma("unroll") for (int _i = 0; _i < 2; ++_i) \
        __builtin_amdgcn_global_load_lds((const unsigned*)((const char*)(gbase) + (voff)[_i]), (PG8_LAS unsigned*)(lds + (bufoff) + ldsw + _i * 8192), 16, 0, 0); } while (0)
#define PG8_LDA(dst, b, h) do { _Pragma("unroll") for (int m = 0; m < 4; ++m) _Pragma("unroll") for (int k = 0; k < 2; ++k) dst[m][k] = *(const PG8_LAS bf16x8*)(lds + PG8_SA(b, h) + aoff + m * 2048 + k * 1024); } while (0)
#define PG8_LDB(dst, b, h) do { _Pragma("unroll") for (int n = 0; n < 2; ++n) _Pragma("unroll") for (int k = 0; k < 2; ++k) dst[n][k] = *(const PG8_LAS bf16x8*)(lds + PG8_SB(b, h) + boff + n * 2048 + k * 1024); } while (0)
#define PG8_MMA(ai, bj, At, Bt) do { __builtin_amdgcn_s_setprio(1); _Pragma("unroll") for (int m = 0; m < 4; ++m) _Pragma("unroll") for (int n = 0; n < 2; ++n) _Pragma("unroll") for (int k = 0; k < 2; ++k) \
        acc[ai][bj][m][n] = __builtin_amdgcn_mfma_f32_16x16x32_bf16(Bt[n][k], At[m][k], acc[ai][bj][m][n], 0, 0, 0); __builtin_amdgcn_s_setprio(0); } while (0)
#define PG8_WAIT_V(n) asm volatile("s_waitcnt vmcnt(" #n ")" ::: "memory")
#define PG8_WAIT_L(n) asm volatile("s_waitcnt lgkmcnt(" #n ")" ::: "memory")
#define PG8_BAR __builtin_amdgcn_s_barrier()
#define PG8_SCHED __builtin_amdgcn_sched_barrier(0)
    Unit cur, nxt; int ui = 0;
    if (!S.next(0, cur)) return;
    f32x4 acc[2][2][4][2];
#pragma unroll
    for (int a = 0; a < 2; ++a)
#pragma unroll
        for (int b = 0; b < 2; ++b)
#pragma unroll
            for (int m = 0; m < 4; ++m)
#pragma unroll
                for (int n = 0; n < 2; ++n) acc[a][b][m][n] = (f32x4){0.f, 0.f, 0.f, 0.f};
    bf16x8 At[4][2], B0[2][2], B1[2][2];
    const char* cA = (const char*)g.A + (size_t)cur.pm * tstep; const char* cB = (const char*)g.Bt + (size_t)cur.pn * tstep;
    S.a_ready(cur);
    if constexpr (SP2) {
        PG8_STAGE(PG8_SB(0, 0), cB, voffB); PG8_STAGE(PG8_SB(0, 1), cB + hstep, voffB); PG8_STAGE(PG8_SA(0, 0), cA, voffA); PG8_STAGE(PG8_SA(0, 1), cA + hstep, voffA);
        if (wr == 1) PG8_BAR;
        PG8_WAIT_V(2); PG8_BAR;
        PG8_STAGE(PG8_SB(1, 0), cB + kstep, voffB); PG8_STAGE(PG8_SA(1, 0), cA + kstep, voffA); PG8_STAGE(PG8_SB(1, 1), cB + hstep + kstep, voffB);
        PG8_WAIT_V(6); PG8_BAR;
    } else {
        PG8_STAGE(PG8_SB(0, 0), cB, voffB); PG8_STAGE(PG8_SA(0, 0), cA, voffA); PG8_STAGE(PG8_SB(0, 1), cB + hstep, voffB); PG8_STAGE(PG8_SA(0, 1), cA + hstep, voffA);
        if (wr == 1) PG8_BAR;
        PG8_WAIT_V(4); PG8_BAR;
        PG8_STAGE(PG8_SB(1, 0), cB + kstep, voffB); PG8_STAGE(PG8_SA(1, 0), cA + kstep, voffA); PG8_STAGE(PG8_SB(1, 1), cB + hstep + kstep, voffB);
        PG8_WAIT_V(6); PG8_BAR;
    }
    for (;;) {
        const bool has_next = S.next(ui + 1, nxt);
        const char* nA = has_next ? (const char*)g.A + (size_t)nxt.pm * tstep : cA; const char* nB = has_next ? (const char*)g.Bt + (size_t)nxt.pn * tstep : cB;
        for (int t = 0; t < nt; t += 2) {
            const bool last = (t == nt - 2);
            const char* a1 = cA + (size_t)(t + 1) * kstep;
            const char* a2 = last ? nA : cA + (size_t)(t + 2) * kstep; const char* b2 = last ? nB : cB + (size_t)(t + 2) * kstep;
            const char* a3 = a2 + kstep; const char* b3 = b2 + kstep;
            if (last && has_next) S.a_ready(nxt);
            if constexpr (SP2) {
            PG8_LDB(B0, 0, 0); PG8_LDB(B1, 0, 1); PG8_SCHED; PG8_LDA(At, 0, 0); PG8_STAGE(PG8_SA(1, 1), a1 + hstep, voffA);
            PG8_WAIT_V(8); PG8_WAIT_L(0); PG8_BAR; PG8_MMA(0, 0, At, B0); PG8_MMA(0, 1, At, B1); PG8_BAR; PG8_SCHED;
            PG8_LDA(At, 0, 1); PG8_STAGE(PG8_SB(0, 0), b2, voffB); PG8_STAGE(PG8_SB(0, 1), b2 + hstep, voffB); PG8_STAGE(PG8_SA(0, 0), a2, voffA);
            PG8_WAIT_V(8); PG8_WAIT_L(0); PG8_BAR; PG8_MMA(1, 0, At, B0); PG8_MMA(1, 1, At, B1); PG8_BAR; PG8_SCHED;
            PG8_LDB(B0, 1, 0); PG8_LDB(B1, 1, 1); PG8_SCHED; PG8_LDA(At, 1, 0); PG8_STAGE(PG8_SA(0, 1), a2 + hstep, voffA);
            PG8_WAIT_V(8); PG8_WAIT_L(0); PG8_BAR; PG8_MMA(0, 0, At, B0); PG8_MMA(0, 1, At, B1); PG8_BAR; PG8_SCHED;
            PG8_LDA(At, 1, 1); PG8_STAGE(PG8_SB(1, 0), b3, voffB); PG8_STAGE(PG8_SB(1, 1), b3 + hstep, voffB); PG8_STAGE(PG8_SA(1, 0), a3, voffA);
            PG8_WAIT_V(8); PG8_WAIT_L(0); PG8_BAR; PG8_MMA(1, 0, At, B0); PG8_MMA(1, 1, At, B1); PG8_BAR; PG8_SCHED;
            } else {
            PG8_LDB(B0, 0, 0); PG8_SCHED; PG8_LDA(At, 0, 0); PG8_STAGE(PG8_SA(1, 1), a1 + hstep, voffA);
            PG8_WAIT_L(8); PG8_BAR; PG8_WAIT_L(0); PG8_MMA(0, 0, At, B0); PG8_BAR; PG8_SCHED;
            PG8_LDB(B1, 0, 1); PG8_STAGE(PG8_SB(0, 0), b2, voffB);
            PG8_BAR; PG8_WAIT_L(0); PG8_MMA(0, 1, At, B1); PG8_BAR;
            PG8_LDA(At, 0, 1); PG8_STAGE(PG8_SA(0, 0), a2, voffA);
            PG8_BAR; PG8_WAIT_L(0); PG8_MMA(1, 0, At, B0); PG8_BAR; PG8_SCHED;
            PG8_STAGE(PG8_SB(0, 1), b2 + hstep, voffB);
            PG8_WAIT_V(6); PG8_BAR; PG8_MMA(1, 1, At, B1); PG8_BAR;
            PG8_LDB(B0, 1, 0); PG8_SCHED; PG8_LDA(At, 1, 0); PG8_STAGE(PG8_SA(0, 1), a2 + hstep, voffA);
            PG8_WAIT_L(8); PG8_BAR; PG8_WAIT_L(0); PG8_MMA(0, 0, At, B0); PG8_BAR; PG8_SCHED;
            PG8_LDB(B1, 1, 1); PG8_STAGE(PG8_SB(1, 0), b3, voffB);
            PG8_BAR; PG8_WAIT_L(0); PG8_MMA(0, 1, At, B1); PG8_BAR;
            PG8_LDA(At, 1, 1); PG8_STAGE(PG8_SA(1, 0), a3, voffA);
            PG8_BAR; PG8_WAIT_L(0); PG8_MMA(1, 0, At, B0); PG8_BAR; PG8_SCHED;
            PG8_STAGE(PG8_SB(1, 1), b3 + hstep, voffB);
            PG8_WAIT_V(6); PG8_BAR; PG8_MMA(1, 1, At, B1); PG8_BAR;
            }
        }
        if constexpr (ALIGN_EPI) { if (wr == 0) PG8_BAR; }
        if constexpr (!Epi::AFTER_DRAIN) { E(acc, cur, wr, wc, fr, fq); S.done(cur); }
        if (!has_next) break;
#pragma unroll
        for (int a = 0; a < 2; ++a)
#pragma unroll
            for (int b = 0; b < 2; ++b)
#pragma unroll
                for (int m = 0; m < 4; ++m)
#pragma unroll
                    for (int n = 0; n < 2; ++n) acc[a][b][m][n] = (f32x4){0.f, 0.f, 0.f, 0.f};
        cur = nxt; cA = nA; cB = nB; ++ui;
        if constexpr (ALIGN_EPI) { if (wr == 1) PG8_BAR; }
    }
    PG8_WAIT_V(0);
    if constexpr (!ALIGN_EPI) { if (wr == 0) PG8_BAR; }
    PG8_BAR;
    if constexpr (Epi::AFTER_DRAIN) { E.fused(acc, cur, wr, wc, fr, fq, lds, wid, lane); S.done(cur); }
#undef PG8_SA
#undef PG8_SB
#undef PG8_STAGE
#undef PG8_LDA
#undef PG8_LDB
#undef PG8_MMA
#undef PG8_WAIT_V
#undef PG8_WAIT_L
#undef PG8_BAR
#undef PG8_SCHED
}
typedef unsigned u32x2 __attribute__((ext_vector_type(2)));
constexpr float ATT_C2 = 0.125f * 1.4426950408889634f;
struct EpiInProj {
    static constexpr bool PERM = false, AFTER_DRAIN = false;
    unsigned char* ws;
    __device__ __forceinline__ void operator()(const f32x4 (&acc)[2][2][4][2], const Unit& u, int wr, int wc, int fr, int fq) const {
        const int pn = u.pn, row0 = u.pm * BM + wr * 64 + fr;
        if (pn >= 3) {
            const size_t boff = (pn < 7) ? WS_QKM : ((pn < 9) ? WS_VM : WS_OM);
            const int ldc = (pn < 7) ? 1024 : 512, c0 = 256 * ((pn < 7) ? (pn - 3) : ((pn < 9) ? (pn - 7) : (pn - 9))) + wc * 32 + 8 * fq;
            bf16_t* base = (bf16_t*)(ws + boff);
#pragma unroll
            for (int ai = 0; ai < 2; ++ai)
#pragma unroll
                for (int m = 0; m < 4; ++m) { bf16_t* rowp = base + (size_t)(row0 + ai * HALF + m * 16) * ldc + c0;
#pragma unroll
                    for (int bj = 0; bj < 2; ++bj) { const f32x4 v0 = acc[ai][bj][m][0], v1 = acc[ai][bj][m][1]; u32x4 w;
                        w.x = cvt_pk_bf16(v0[0], v0[1]); w.y = cvt_pk_bf16(v0[2], v0[3]); w.z = cvt_pk_bf16(v1[0], v1[1]); w.w = cvt_pk_bf16(v1[2], v1[3]);
                        *(u32x4*)(rowp + bj * HALF) = w; } }
            return;
        }
        const bool isv = (pn == 2 && wc >= 2), isq = (pn < 2);
        const size_t boff = isq ? WS_Q : (isv ? WS_V : WS_K);
        const int ldc = isq ? 512 : 128, hcol = isq ? (4 * pn + wc) * 64 : (wc & 1) * 64;
        bf16_t* base = (bf16_t*)(ws + boff);
        const float* g = (const float*)(ws + WS_QKG) + (isq ? 0 : 64);
        const float* tabc = (const float*)(ws + WS_TABC); const float* tabs = (const float*)(ws + WS_TABS);
        f32x4 gv[4];
#pragma unroll
        for (int dq = 0; dq < 4; ++dq) gv[dq] = *(const f32x4*)(g + 16 * dq + 4 * fq);
        const float osc = isq ? ATT_C2 : 1.0f;
#pragma unroll
        for (int ai = 0; ai < 2; ++ai)
#pragma unroll
            for (int m = 0; m < 4; ++m) {
                const int r = row0 + ai * HALF + m * 16;
                f32x4 y[4];
#pragma unroll
                for (int dq = 0; dq < 4; ++dq) y[dq] = acc[ai][dq >> 1][m][dq & 1];
                if (!isv) {
                    float ss = 0.f;
#pragma unroll
                    for (int dq = 0; dq < 4; ++dq) ss += (y[dq][0] * y[dq][0] + y[dq][1] * y[dq][1]) + (y[dq][2] * y[dq][2] + y[dq][3] * y[dq][3]);
                    ss += __shfl_xor(ss, 16); ss += __shfl_xor(ss, 32);
                    const float rstd = 1.0f / sqrtf(ss * (1.0f / 64.0f) + 1e-6f);
#pragma unroll
                    for (int dq = 0; dq < 4; ++dq) y[dq] = y[dq] * rstd * gv[dq];
                    const int t = r & 4095, pr = t >> 6, pc = t & 63;
                    const f32x4 cr = *(const f32x4*)(tabc + pr * 16 + 4 * fq), sr = *(const f32x4*)(tabs + pr * 16 + 4 * fq);
                    const f32x4 cc = *(const f32x4*)(tabc + pc * 16 + 4 * fq), sc = *(const f32x4*)(tabs + pc * 16 + 4 * fq);
                    const f32x4 o0 = y[0] * cr - y[1] * sr, o1 = y[1] * cr + y[0] * sr, o2 = y[2] * cc - y[3] * sc, o3 = y[3] * cc + y[2] * sc;
                    y[0] = o0 * osc; y[1] = o1 * osc; y[2] = o2 * osc; y[3] = o3 * osc;
                }
                bf16_t* rowp = base + (size_t)r * ldc + hcol + 4 * fq;
#pragma unroll
                for (int dq = 0; dq < 4; ++dq) { u32x2 w; w.x = cvt_pk_bf16(y[dq][0], y[dq][1]); w.y = cvt_pk_bf16(y[dq][2], y[dq][3]); *(u32x2*)(rowp + 16 * dq) = w; }
            }
    }
};
struct EpiResGate {
    static constexpr bool PERM = false, AFTER_DRAIN = false;
    const float* base; float* out; const float* gate;
    __device__ __forceinline__ void operator()(const f32x4 (&acc)[2][2][4][2], const Unit& u, int wr, int wc, int fr, int fq) const {
        const int row0 = u.pm * BM + wr * 64 + fr, col0 = u.pn * BM + wc * 32 + 4 * fq, b = (u.pm * BM) >> 12;
        f32x4 gv[2][2];
#pragma unroll
        for (int bj = 0; bj < 2; ++bj)
#pragma unroll
            for (int n = 0; n < 2; ++n) gv[bj][n] = *(const f32x4*)(gate + (size_t)b * 6144 + col0 + bj * HALF + n * 16);
#pragma unroll
        for (int ai = 0; ai < 2; ++ai)
#pragma unroll
            for (int m = 0; m < 4; ++m) { const size_t off = (size_t)(row0 + ai * HALF + m * 16) * 1024 + col0;
#pragma unroll
                for (int bj = 0; bj < 2; ++bj)
#pragma unroll
                    for (int n = 0; n < 2; ++n) { const f32x4 bs = *(const f32x4*)(base + off + bj * HALF + n * 16); *(f32x4*)(out + off + bj * HALF + n * 16) = bs + gv[bj][n] * acc[ai][bj][m][n]; } }
    }
};
struct EpiSwiGLU {
    static constexpr bool PERM = false, AFTER_DRAIN = false;
    bf16_t* act;
    __device__ __forceinline__ void operator()(const f32x4 (&acc)[2][2][4][2], const Unit& u, int wr, int wc, int fr, int fq) const {
        const int row0 = u.pm * BM + wr * 64 + fr, c0 = u.pn * HALF + wc * 32 + 8 * fq;
#pragma unroll
        for (int ai = 0; ai < 2; ++ai)
#pragma unroll
            for (int m = 0; m < 4; ++m) { float o[8];
#pragma unroll
                for (int n = 0; n < 2; ++n)
#pragma unroll
                    for (int e = 0; e < 4; ++e) { const float gt = acc[ai][0][m][n][e], up = acc[ai][1][m][n][e];
                        o[4 * n + e] = gt * __builtin_amdgcn_rcpf(1.0f + __builtin_amdgcn_exp2f(-1.4426950408889634f * gt)) * up; }
                u32x4 w; w.x = cvt_pk_bf16(o[0], o[1]); w.y = cvt_pk_bf16(o[2], o[3]); w.z = cvt_pk_bf16(o[4], o[5]); w.w = cvt_pk_bf16(o[6], o[7]);
                *(u32x4*)(act + (size_t)(row0 + ai * HALF + m * 16) * 2816 + c0) = w; }
    }
};
template <class Epi, class Sched>
__device__ __forceinline__ void gemm_simple(const Gemm g, const Sched& S, const Epi& E) {
    const int tid = threadIdx.x, wid = __builtin_amdgcn_readfirstlane(tid >> 6), lane = tid & 63, wr = wid >> 2, wc = wid & 3, fr = lane & 15, fq = lane >> 4;
    const int K = g.K; Unit u;
    for (int i = 0; S.next(i, u); ++i) {
        f32x4 acc[2][2][4][2];
#pragma unroll
        for (int a = 0; a < 2; ++a)
#pragma unroll
            for (int b = 0; b < 2; ++b)
#pragma unroll
                for (int m = 0; m < 4; ++m)
#pragma unroll
                    for (int n = 0; n < 2; ++n) acc[a][b][m][n] = (f32x4){0.f, 0.f, 0.f, 0.f};
        const bf16_t* Ab = g.A + (size_t)(u.pm * BM + wr * 64 + fr) * K + fq * 8;
        const bf16_t* Bb = g.Bt + (size_t)(u.pn * BM + wc * 32 + fr) * K + fq * 8;
        for (int k0 = 0; k0 < K; k0 += 32) {
            bf16x8 a[2][4], b[2][2];
#pragma unroll
            for (int ai = 0; ai < 2; ++ai)
#pragma unroll
                for (int m = 0; m < 4; ++m) a[ai][m] = *(const bf16x8*)(Ab + (size_t)(ai * HALF + m * 16) * K + k0);
#pragma unroll
            for (int bj = 0; bj < 2; ++bj)
#pragma unroll
                for (int n = 0; n < 2; ++n) b[bj][n] = *(const bf16x8*)(Bb + (size_t)(bj * HALF + n * 16) * K + k0);
#pragma unroll
            for (int ai = 0; ai < 2; ++ai)
#pragma unroll
                for (int bj = 0; bj < 2; ++bj)
#pragma unroll
                    for (int m = 0; m < 4; ++m)
#pragma unroll
                        for (int n = 0; n < 2; ++n) acc[ai][bj][m][n] = __builtin_amdgcn_mfma_f32_16x16x32_bf16(b[bj][n], a[ai][m], acc[ai][bj][m][n], 0, 0, 0);
        }
        E(acc, u, wr, wc, fr, fq);
    }
}
}
#ifndef PG8_SP2
#define PG8_SP2 true
#endif
#ifndef PG8_ALIGN
#define PG8_ALIGN true
#endif
#include <hip/hip_bf16.h>
#include <cmath>
namespace attn_body {
using bf16=__hip_bfloat16;
using bf16x8=__attribute__((ext_vector_type(8)))short;
using s16x4=__attribute__((ext_vector_type(4)))short;
using f32x16=__attribute__((ext_vector_type(16)))float;
using u32x4=__attribute__((ext_vector_type(4)))unsigned;
constexpr int BATCH=8,NHEAD=8,NKV=2,SEQ=4096,D=64,QP=512,KP=128,OP=1024;
constexpr int NW=8,QBLK=32,QB=QBLK*NW,KVBLK=64,NQB=SEQ/QB;
constexpr int ATTN_UNIT_ROWS=QB;
__device__ __forceinline__ int crow(int r,int hi){return (r&3)+8*(r>>2)+4*hi;}
#define SBAR() __builtin_amdgcn_sched_barrier(0)
__device__ __forceinline__ void cmask(f32x16&p0,f32x16&p1,int jb,int qrel,int hi){
  const float NEG=-INFINITY; int kb=64*jb+4*hi;
  #pragma unroll
  for(int r=0;r<16;++r){int kv=kb+(r&3)+8*(r>>2); if(kv>qrel)p0[r]=NEG; if(kv+32>qrel)p1[r]=NEG;}
}

constexpr int NSLOT=3, SLOTB=8192;
constexpr int LDS_K=0, LDS_V=NSLOT*SLOTB, LDS_WS=2*NSLOT*SLOTB, LDS_OST=LDS_WS+NW*64*4, LDS_BYTES=LDS_OST+NW*4096;
constexpr float C2=0.125f*1.4426950408889634f;
__device__ __forceinline__ void glds16(const void*gsrc,unsigned lds_dst){unsigned keep;
  asm volatile("s_mov_b32 %0, m0\n\ts_mov_b32 m0, %2\n\ts_nop 0\n\tglobal_load_lds_dwordx4 %1, off\n\ts_mov_b32 m0, %0":"=&s"(keep):"v"(gsrc),"s"(lds_dst):"memory");}
__device__ __forceinline__ float max3f(float a,float b,float c){float r;asm("v_max3_f32 %0, %1, %2, %3":"=v"(r):"v"(a),"v"(b),"v"(c));return r;}
__device__ __forceinline__ float max2f(float a,float b){float r;asm("v_max_f32_e32 %0, %1, %2":"=v"(r):"v"(a),"v"(b));return r;}
__device__ __forceinline__ float fadd_s(float a,float b){float r;asm("v_add_f32_e32 %0, %1, %2":"=v"(r):"v"(a),"v"(b));return r;}
__device__ __forceinline__ float fsub_s(float a,float b){float r;asm("v_sub_f32_e32 %0, %1, %2":"=v"(r):"v"(a),"v"(b));return r;}
typedef float f32x2_t __attribute__((ext_vector_type(2))); typedef __bf16 bf16x2_t __attribute__((ext_vector_type(2)));
__device__ __forceinline__ unsigned cvtpk_s(float lo,float hi){f32x2_t v={lo,hi};bf16x2_t b=__builtin_convertvector(v,bf16x2_t);return __builtin_bit_cast(unsigned,b);}
#define WAIT_BAR(N) asm volatile("s_waitcnt vmcnt(" #N ") lgkmcnt(0)\n\ts_barrier":::"memory")

__device__ __forceinline__ void qkt(f32x16&p0,f32x16&p1,const char*Kslot,const bf16x8*qr,const f32x16&negm,int r32,int hi){
  const char*kb=Kslot+hi*1024+r32*16;
  #pragma unroll
  for(int d0=0;d0<4;++d0){
    const bf16x8 b0=*reinterpret_cast<const bf16x8*>(kb+d0*2048);
    const bf16x8 b1=*reinterpret_cast<const bf16x8*>(kb+d0*2048+512);
    if(d0==0){p0=__builtin_amdgcn_mfma_f32_32x32x16_bf16(b0,qr[0],negm,0,0,0);p1=__builtin_amdgcn_mfma_f32_32x32x16_bf16(b1,qr[0],negm,0,0,0);}
    else{p0=__builtin_amdgcn_mfma_f32_32x32x16_bf16(b0,qr[d0],p0,0,0,0);p1=__builtin_amdgcn_mfma_f32_32x32x16_bf16(b1,qr[d0],p1,0,0,0);}}
}
typedef __attribute__((address_space(3))) const char* lds_cptr;
typedef short v4i16_t __attribute__((ext_vector_type(4)));
__device__ __forceinline__ void kload8(bf16x8*kf,lds_cptr kp){
  kf[0]=*(const __attribute__((address_space(3))) bf16x8*)(kp);      kf[1]=*(const __attribute__((address_space(3))) bf16x8*)(kp+512);
  kf[2]=*(const __attribute__((address_space(3))) bf16x8*)(kp+2048); kf[3]=*(const __attribute__((address_space(3))) bf16x8*)(kp+2560);
  kf[4]=*(const __attribute__((address_space(3))) bf16x8*)(kp+4096); kf[5]=*(const __attribute__((address_space(3))) bf16x8*)(kp+4608);
  kf[6]=*(const __attribute__((address_space(3))) bf16x8*)(kp+6144); kf[7]=*(const __attribute__((address_space(3))) bf16x8*)(kp+6656);
}
__device__ __forceinline__ void kload2(bf16x8*kf,lds_cptr kp,int j){ kf[2*j]=*(const __attribute__((address_space(3))) bf16x8*)(kp+j*2048); kf[2*j+1]=*(const __attribute__((address_space(3))) bf16x8*)(kp+j*2048+512); }
__device__ __forceinline__ s16x4 vtr(lds_cptr p){ return __builtin_bit_cast(s16x4,__builtin_amdgcn_ds_read_tr16_b64_v4i16((__attribute__((address_space(3))) v4i16_t*)p)); }
__device__ __forceinline__ float rowmax(const f32x16&p0,const f32x16&p1){
  float a=max3f(p0[0],p0[1],p1[0]),b=max3f(p0[2],p0[3],p1[1]);a=max3f(a,p1[2],p1[3]);
  #pragma unroll
  for(int r=4;r<16;r+=4){a=max3f(a,p0[r],p0[r+1]);b=max3f(b,p0[r+2],p0[r+3]);a=max3f(a,p1[r],p1[r+1]);b=max3f(b,p1[r+2],p1[r+3]);}
  const float m=max2f(a,b);
  auto rr=__builtin_amdgcn_permlane32_swap(__float_as_uint(m),__float_as_uint(m),false,false);
  return max2f(__uint_as_float(rr[0]),__uint_as_float(rr[1]));
}
__device__ __forceinline__ void pv(f32x16*o,int vb,bf16x8 pa0,bf16x8 pa1,bf16x8 pa2,bf16x8 pa3){
  #pragma unroll
  for(int d0=0;d0<2;++d0){s16x4 lo[4],hi[4];
    #pragma unroll
    for(int ks=0;ks<4;++ks){
      asm volatile("ds_read_b64_tr_b16 %0,%1 offset:%c2":"=&v"(lo[ks]):"v"(vb),"i"(d0*4096+ks*1024):"memory");
      asm volatile("ds_read_b64_tr_b16 %0,%1 offset:%c2":"=&v"(hi[ks]):"v"(vb),"i"(d0*4096+ks*1024+512):"memory");}
    asm volatile("s_waitcnt lgkmcnt(0)":::"memory");SBAR();
    #define PK(k) (bf16x8){lo[k][0],lo[k][1],lo[k][2],lo[k][3],hi[k][0],hi[k][1],hi[k][2],hi[k][3]}
    o[d0]=__builtin_amdgcn_mfma_f32_32x32x16_bf16(pa0,PK(0),o[d0],0,0,0);
    o[d0]=__builtin_amdgcn_mfma_f32_32x32x16_bf16(pa1,PK(1),o[d0],0,0,0);
    o[d0]=__builtin_amdgcn_mfma_f32_32x32x16_bf16(pa2,PK(2),o[d0],0,0,0);
    o[d0]=__builtin_amdgcn_mfma_f32_32x32x16_bf16(pa3,PK(3),o[d0],0,0,0);
    #undef PK
  }
}

#ifndef ATTN_STORE16
#define ATTN_STORE16(p,v) (*(u32x4*)(p)=(v))
#endif
template<int THRL> __device__ __forceinline__ void attn_unit(int b,int h,int qb,const bf16*Q,const bf16*__restrict__ K,const bf16*__restrict__ V,bf16*O,char*shm){
  const int tid=threadIdx.x,lane=tid&63,r32=lane&31,hi=lane>>5; const int wid=__builtin_amdgcn_readfirstlane(tid>>6);
  const long rowbase=(long)b*SEQ; const int q0=qb*QB;
  const bf16*Qw=Q+(rowbase+q0+wid*QBLK)*QP+h*D;
  const int kvh=h/(NHEAD/NKV); const bf16*Kh=K+rowbase*KP+kvh*D,*Vh=V+rowbase*KP+kvh*D;
  const unsigned lds0=(unsigned)(uintptr_t)shm;
  float*wsf=(float*)(shm+LDS_WS)+wid*64;
  const bf16*ksrc=Kh+(long)lane*KP+wid*8;
  const bf16*vsrc=Vh+(long)(16*(wid&3)+(lane>>2))*KP+(wid>>2)*32+(lane&3)*8;
  const unsigned kdst=lds0+LDS_K+wid*1024, vdst=lds0+LDS_V+wid*1024;
  #define DMA_K(t,slot) glds16(ksrc+(long)(t)*KVBLK*KP,(unsigned)__builtin_amdgcn_readfirstlane(kdst+(slot)))
  #define DMA_V(t,slot) glds16(vsrc+(long)(t)*KVBLK*KP,(unsigned)__builtin_amdgcn_readfirstlane(vdst+(slot)))
  const int vb0=(int)(lds0+LDS_V)+((lane>>4)&1)*32+(lane&3)*8+(4*hi+((lane&15)>>2))*64;
  const char*Kbase=shm+LDS_K; bf16x8 kf[8];
  const lds_cptr shm3=(lds_cptr)shm; const lds_cptr kp0=shm3+LDS_K+hi*1024+r32*16; const lds_cptr vp0=shm3+LDS_V+((lane>>4)&1)*32+(lane&3)*8+(4*hi+((lane&15)>>2))*64;
  const int NT=SEQ/KVBLK;
  DMA_K(0,0);DMA_V(0,0);DMA_K(1,SLOTB);
  bf16x8 qr[4];
  #pragma unroll
  for(int d0=0;d0<4;++d0)qr[d0]=*reinterpret_cast<const bf16x8*>(&Qw[(long)r32*QP+d0*16+hi*8]);
  float mhat=0.f,l_reg=0.f;f32x16 o[2];o[0]=f32x16{};o[1]=f32x16{};f32x16 negm=f32x16{};asm volatile("":"+v"(negm));
  const int qrel=wid*QBLK+r32;
  #define CMASK(P0,P1,t) do{}while(0)
  bool resc=false;
  #define START(P0,P1) do{ const float rm=rowmax(P0,P1); resc=false; \
    { const float dl=rm; mhat=fadd_s(mhat,dl); \
      _Pragma("unroll") for(int r=0;r<16;++r){P0[r]=fsub_s(P0[r],dl);P1[r]=fsub_s(P1[r],dl);} \
      _Pragma("unroll") for(int r=0;r<16;++r)negm[r]=-mhat; asm volatile("":"+v"(negm)); } \
    _Pragma("unroll") for(int r=0;r<16;++r)P0[r]=__builtin_amdgcn_exp2f(P0[r]); }while(0)
  #define RESC() do{ if(resc){ asm volatile("s_waitcnt lgkmcnt(0)":::"memory"); \
      _Pragma("unroll") for(int d_=0;d_<2;++d_) _Pragma("unroll") for(int r=0;r<16;++r)o[d_][r]*=wsf[crow(r,hi)]; } }while(0)
  f32x16 pA0,pA1,pB0,pB1;
  int sl_prev=0,sl_cur=0,sl_next=SLOTB;
  #define ROT() do{sl_prev=sl_cur;sl_cur=sl_next;sl_next=(sl_next==(NSLOT-1)*SLOTB)?0:sl_next+SLOTB;}while(0)
  DMA_K(2,2*SLOTB);
  WAIT_BAR(3);
  qkt(pA0,pA1,Kbase,qr,negm,r32,hi);asm volatile("s_nop 15\n\ts_nop 7":"+v"(pA0),"+v"(pA1));CMASK(pA0,pA1,0);
  START(pA0,pA1);
  _Pragma("unroll") for(int r=0;r<16;++r)pA1[r]=__builtin_amdgcn_exp2f(pA1[r]);
  WAIT_BAR(0);
  DMA_K(3,0);DMA_V(1,SLOTB);
  ROT();
  kload8(kf,kp0+sl_cur);
  WAIT_BAR(2);
  s16x4 vlo[8],vhi[8]; u32x4 pw0,pw1,pw2,pw3;
  #define PKW(P,B) cvtpk_s(P[B],P[B+1])
  #define PAF(k) __builtin_bit_cast(bf16x8,pw##k)
  #define VFR(i) (bf16x8){vlo[i][0],vlo[i][1],vlo[i][2],vlo[i][3],vhi[i][0],vhi[i][1],vhi[i][2],vhi[i][3]}
  #define PIN(x) asm volatile("":"+v"(x))
  #define MX3(a,b,c) __builtin_fmaxf(__builtin_fmaxf((a),(b)),(c))
  #define GAPA(MF,A0,A1,A2,A3,W0,W1,PW) do{ MF; sacc+=A0; sacc+=A1; sacc+=A2; sacc+=A3; PIN(sacc); W0; W1; PIN(PW); SBAR(); }while(0)
  #define EX(v) __builtin_amdgcn_exp2f(v)
  #define GAPB(MF,X,B) do{ MF; X[B]=EX(X[B]); X[B+1]=EX(X[B+1]); X[B+2]=EX(X[B+2]); X[B+3]=EX(X[B+3]); PIN(X); SBAR(); }while(0)
  #define VRD(i) do{ vlo[i]=vtr(vp_+(((i)>>2)*4096+((i)&3)*1024)); vhi[i]=vtr(vp_+(((i)>>2)*4096+((i)&3)*1024+512)); }while(0)
  #define KRD(G,j) do{ if(G){ kload2(kf,kp0+sl_next,j); SBAR(); } }while(0)
  #define STEP(C0,C1,P0,P1,t,GK,GV,GL) do{ SBAR(); \
    const lds_cptr vp_=vp0+sl_prev; \
    VRD(0); SBAR(); float sacc=(P0[0]+P0[1]); \
    GAPA(C0=__builtin_amdgcn_mfma_f32_32x32x16_bf16(kf[0],qr[0],negm,0,0,0), P0[2],P0[3],P0[4],P0[5],     pw0[0]=PKW(P0,0), pw0[1]=PKW(P0,2), pw0); \
    VRD(4); SBAR(); GAPA(C1=__builtin_amdgcn_mfma_f32_32x32x16_bf16(kf[1],qr[0],negm,0,0,0), P0[6],P0[7],P0[8],P0[9],     pw0[2]=PKW(P0,4), pw0[3]=PKW(P0,6), pw0); \
    VRD(1); SBAR(); GAPA(C0=__builtin_amdgcn_mfma_f32_32x32x16_bf16(kf[2],qr[1],C0,0,0,0),   P0[10],P0[11],P0[12],P0[13], pw1[0]=PKW(P0,8), pw1[1]=PKW(P0,10), pw1); \
    VRD(5); SBAR(); GAPA(C1=__builtin_amdgcn_mfma_f32_32x32x16_bf16(kf[3],qr[1],C1,0,0,0),   P0[14],P0[15],P1[0],P1[1],   pw1[2]=PKW(P0,12),pw1[3]=PKW(P0,14), pw1); \
    VRD(2); SBAR(); GAPA(C0=__builtin_amdgcn_mfma_f32_32x32x16_bf16(kf[4],qr[2],C0,0,0,0),   P1[2],P1[3],P1[4],P1[5],     pw2[0]=PKW(P1,0), pw2[1]=PKW(P1,2), pw2); \
    VRD(6); SBAR(); GAPA(C1=__builtin_amdgcn_mfma_f32_32x32x16_bf16(kf[5],qr[2],C1,0,0,0),   P1[6],P1[7],P1[8],P1[9],     pw2[2]=PKW(P1,4), pw2[3]=PKW(P1,6), pw2); \
    VRD(3); SBAR(); GAPA(C0=__builtin_amdgcn_mfma_f32_32x32x16_bf16(kf[6],qr[3],C0,0,0,0),   P1[10],P1[11],P1[12],P1[13], pw3[0]=PKW(P1,8), pw3[1]=PKW(P1,10), pw3); \
    VRD(7); SBAR(); GAPA(C1=__builtin_amdgcn_mfma_f32_32x32x16_bf16(kf[7],qr[3],C1,0,0,0),   P1[14],P1[15],0.f,0.f,       pw3[2]=PKW(P1,12),pw3[3]=PKW(P1,14), pw3); \
    l_reg+=sacc; \
    if(GK){DMA_K((t)+3,sl_cur);} if(GV){DMA_V((t)+1,sl_next);} \
    CMASK(C0,C1,t); \
    { float a=MX3(C0[0],C0[1],C1[0]),b=MX3(C0[2],C0[3],C1[1]); a=MX3(a,C1[2],C1[3]); \
      _Pragma("unroll") for(int r=4;r<16;r+=4){a=MX3(a,C0[r],C0[r+1]);b=MX3(b,C0[r+2],C0[r+3]);a=MX3(a,C1[r],C1[r+1]);b=MX3(b,C1[r+2],C1[r+3]);} \
      float rm=__builtin_fmaxf(a,b); { auto rr=__builtin_amdgcn_permlane32_swap(__float_as_uint(rm),__float_as_uint(rm),false,false); rm=__builtin_fmaxf(__uint_as_float(rr[0]),__uint_as_float(rr[1])); } \
      resc=false; \
      if(__builtin_expect(__any(rm>(float)THRL),0)){ const float dl=__builtin_fmaxf(rm,0.f); mhat+=dl; \
        _Pragma("unroll") for(int r=0;r<16;++r){C0[r]-=dl;C1[r]-=dl;} \
        _Pragma("unroll") for(int r=0;r<16;++r)negm[r]=-mhat; asm volatile("":"+v"(negm)); \
        const float f=__builtin_amdgcn_exp2f(-dl); l_reg*=f; if(hi==0)wsf[r32]=f; resc=true; } } \
    SBAR(); \
    GAPB(o[0]=__builtin_amdgcn_mfma_f32_32x32x16_bf16(PAF(0),VFR(0),o[0],0,0,0), C0,0); \
    GAPB(o[1]=__builtin_amdgcn_mfma_f32_32x32x16_bf16(PAF(0),VFR(4),o[1],0,0,0), C0,4); \
    KRD(GL,0); GAPB(o[0]=__builtin_amdgcn_mfma_f32_32x32x16_bf16(PAF(1),VFR(1),o[0],0,0,0), C0,8); \
    KRD(GL,1); GAPB(o[1]=__builtin_amdgcn_mfma_f32_32x32x16_bf16(PAF(1),VFR(5),o[1],0,0,0), C0,12); \
    KRD(GL,2); GAPB(o[0]=__builtin_amdgcn_mfma_f32_32x32x16_bf16(PAF(2),VFR(2),o[0],0,0,0), C1,0); \
    KRD(GL,3); GAPB(o[1]=__builtin_amdgcn_mfma_f32_32x32x16_bf16(PAF(2),VFR(6),o[1],0,0,0), C1,4); \
    GAPB(o[0]=__builtin_amdgcn_mfma_f32_32x32x16_bf16(PAF(3),VFR(3),o[0],0,0,0), C1,8); \
    GAPB(o[1]=__builtin_amdgcn_mfma_f32_32x32x16_bf16(PAF(3),VFR(7),o[1],0,0,0), C1,12); \
    }while(0)
  int t=1;
  #undef CMASK
  #define CMASK(P0,P1,t) do{}while(0)
  for(;t+5<NT;t+=2){
    STEP(pB0,pB1,pA0,pA1,t,true,true,true);     WAIT_BAR(2); RESC(); ROT();
    STEP(pA0,pA1,pB0,pB1,t+1,true,true,true);   WAIT_BAR(2); RESC(); ROT();
  }
  #undef CMASK
  #define CMASK(P0,P1,t) do{}while(0)
  #define ENDW(tt) do{ if((tt)+3<NT){WAIT_BAR(2);} else if((tt)+2<NT){WAIT_BAR(1);} else {WAIT_BAR(0);} }while(0)
  for(;t+1<NT;t+=2){
    STEP(pB0,pB1,pA0,pA1,t,(t+3<NT),(t+1<NT),(t+1<NT));       ENDW(t);   RESC(); ROT();
    STEP(pA0,pA1,pB0,pB1,t+1,(t+4<NT),(t+2<NT),(t+2<NT));     ENDW(t+1); RESC(); ROT();
  }
  STEP(pB0,pB1,pA0,pA1,NT-1,false,false,false); RESC();
  { float sacc=pB0[0]+pB0[1]; _Pragma("unroll") for(int r=2;r<16;++r)sacc+=pB0[r]; _Pragma("unroll") for(int r=0;r<16;++r)sacc+=pB1[r]; l_reg+=sacc;
    pw0=(u32x4){PKW(pB0,0),PKW(pB0,2),PKW(pB0,4),PKW(pB0,6)};pw1=(u32x4){PKW(pB0,8),PKW(pB0,10),PKW(pB0,12),PKW(pB0,14)};pw2=(u32x4){PKW(pB1,0),PKW(pB1,2),PKW(pB1,4),PKW(pB1,6)};pw3=(u32x4){PKW(pB1,8),PKW(pB1,10),PKW(pB1,12),PKW(pB1,14)};
    SBAR(); pv(o,vb0+sl_cur,PAF(0),PAF(1),PAF(2),PAF(3)); }
  #undef PKW
  #undef PAF
  #undef VFR
  #undef PIN
  #undef MX3
  #undef GAPA
  #undef GAPB
  #undef EX
  #undef VRD
  #undef KRD
  #undef STEP
  #undef ENDW
  {auto rr=__builtin_amdgcn_permlane32_swap(__float_as_uint(l_reg),__float_as_uint(l_reg),false,false);l_reg=__uint_as_float(rr[0])+__uint_as_float(rr[1]);}
  if(hi==0)wsf[32+r32]=l_reg;asm volatile("s_waitcnt lgkmcnt(0)":::"memory");
  float rli[16];
  #pragma unroll
  for(int r=0;r<16;++r)rli[r]=__builtin_amdgcn_rcpf(wsf[32+crow(r,hi)]);
  bf16*Ow=O+(rowbase+q0+wid*QBLK)*OP+h*D;
  { bf16*stg=(bf16*)(shm+LDS_OST)+wid*2048;
    #pragma unroll
    for(int r=0;r<16;++r){const int orow=crow(r,hi);
      #pragma unroll
      for(int d0=0;d0<2;++d0)stg[orow*64+d0*32+r32]=__float2bfloat16(o[d0][r]*rli[r]);}
    asm volatile("s_waitcnt lgkmcnt(0)":::"memory");
    #pragma unroll
    for(int i=0;i<4;++i){const int row=i*8+(lane>>3),ch=lane&7; const u32x4 v=*(const u32x4*)(stg+row*64+ch*8); ATTN_STORE16(Ow+(long)row*OP+ch*8,v);} }
  asm volatile("s_waitcnt lgkmcnt(0)\n\ts_barrier":::"memory");
  #undef DMA_K
  #undef DMA_V
  #undef CMASK
  #undef START
  #undef RESC
  #undef ROT
}
constexpr int ATTN_LDS_BYTES=LDS_BYTES;
struct AttnTensors { const bf16* Q; const bf16* K; const bf16* V; bf16* O; };
struct AttnUnit { int bh; int qb; };
struct StaticOrder {
  int vcu, G;
  __device__ __forceinline__ explicit StaticOrder(int grid,int block):vcu((grid%8==0)?(block%8)*(grid/8)+block/8:block),G(grid){}
  __device__ __forceinline__ bool next(int i,AttnUnit&u)const{ const int per=(BATCH*NHEAD*NQB+G-1)/G; if(i>=per)return false; const int U=vcu*per+i; if(U>=BATCH*NHEAD*NQB)return false; u.bh=U/NQB; u.qb=U%NQB; return true; }
};
template<class Sched,int THRL=8> __device__ __forceinline__ void attn_phase(char*lds,const AttnTensors&T,const Sched&S){
  AttnUnit u;
  for(int i=0;S.next(i,u);++i){ attn_unit<THRL>(u.bh/NHEAD,u.bh%NHEAD,u.qb,T.Q,T.K,T.V,T.O,lds); }
}
#undef SBAR
#undef WAIT_BAR
}
#define GAS __attribute__((address_space(1)))
#define LAS __attribute__((address_space(3)))
typedef unsigned short bf16;
typedef unsigned v4u __attribute__((ext_vector_type(4)));
typedef float f32x4 __attribute__((ext_vector_type(4)));
typedef short bf16x8 __attribute__((ext_vector_type(8)));
typedef GAS unsigned gu32;
typedef GAS unsigned long long gu64;
#define RLX_AGENT __ATOMIC_RELAXED, __HIP_MEMORY_SCOPE_AGENT
#define LDS_WAIT() asm volatile("s_waitcnt lgkmcnt(0)" ::: "memory")
#define VM_WAIT() asm volatile("s_waitcnt vmcnt(0)" ::: "memory")
__device__ __forceinline__ unsigned long long rt() { return __builtin_amdgcn_s_memrealtime(); }
__device__ __forceinline__ unsigned f2bf(float f) { unsigned u = __builtin_bit_cast(unsigned, f); return (u + 0x7fffu + ((u >> 16) & 1u)) >> 16; }
__device__ __forceinline__ unsigned pk2(float lo, float hi) { return f2bf(lo) | (f2bf(hi) << 16); }

#define XB_TMO      128
#define XB_XCNT(j)  (256  + 64 * (j))
#define XB_XSUB(j)  (1280 + 64 * (j))
#define XB_XGEN(j)  (2304 + 64 * (j))
#define XB_TOP      3328
#define XB_TOPGEN   3392
#define XCD_BAR_WORDS 3456
#ifndef XB_SPIN_CAP
#define XB_SPIN_CAP (1u << 26)
#endif

__device__ __forceinline__ unsigned xb_ld(unsigned* p)              { return __hip_atomic_load(p, __ATOMIC_RELAXED, __HIP_MEMORY_SCOPE_AGENT); }
__device__ __forceinline__ unsigned xb_add(unsigned* p, unsigned v) { return __hip_atomic_fetch_add(p, v, __ATOMIC_RELAXED, __HIP_MEMORY_SCOPE_AGENT); }
__device__ __forceinline__ unsigned xb_xcc_id() { return (unsigned)__builtin_amdgcn_s_getreg((3 << 11) | 20) & 0xFu; }
#define XB_SPIN(cond, bar) do { unsigned _sp = 0; while (cond) { __builtin_amdgcn_s_sleep(1); \
    if ((++_sp & 255u) == 0u) { if (xb_ld(&(bar)[XB_TMO])) break; if (_sp > XB_SPIN_CAP) { atomicAdd(&(bar)[XB_TMO], 1u); break; } } } } while (0)

struct XcdBarrier {
    unsigned* bar; unsigned x;
    volatile LAS unsigned* st;
};

__device__ __forceinline__ XcdBarrier xcd_barrier_post(unsigned* bar, volatile LAS unsigned* st) {
    XcdBarrier b; b.bar = bar; b.x = xb_xcc_id(); b.st = st;
    if (threadIdx.x == 0) (void)xb_add(&bar[XB_XCNT(b.x)], 1u);
    return b;
}
__device__ __forceinline__ void xcd_barrier_complete(unsigned* bar, unsigned x, unsigned& nloc, unsigned& nx) {
    const unsigned G = gridDim.x * gridDim.y * gridDim.z;
    unsigned sum, cnt, mine, sp = 0u;
    for (;;) {
        sum = 0u; cnt = 0u; mine = 0u;
#pragma unroll
        for (unsigned j = 0; j < 16; ++j) { const unsigned c = xb_ld(&bar[XB_XCNT(j)]); sum += c; cnt += (c > 0u) ? 1u : 0u; mine = (j == x) ? c : mine; }
        if (sum == G) break;
        __builtin_amdgcn_s_sleep(1);
        if ((++sp & 255u) == 0u) { if (xb_ld(&bar[XB_TMO])) break; if (sp > XB_SPIN_CAP) { atomicAdd(&bar[XB_TMO], 1u); break; } }
    }
    nloc = mine > 0u ? mine : 1u; nx = cnt > 0u ? cnt : 1u;
}

__device__ __forceinline__ void xcd_barrier(const XcdBarrier& b) {
    asm volatile("s_waitcnt vmcnt(0)" ::: "memory");
    __syncthreads();
    if (threadIdx.x == 0) {
        unsigned* bar = b.bar;
        __builtin_amdgcn_s_waitcnt(0);
        unsigned nloc = b.st[0], nx = b.st[1];
        if (nloc == 0u) { xcd_barrier_complete(bar, b.x, nloc, nx); b.st[0] = nloc; b.st[1] = nx; }
        const unsigned old = xb_add(&bar[XB_XSUB(b.x)], 1u);
        const unsigned gen = old / nloc;
        if (old + 1u == (gen + 1u) * nloc) {
            __builtin_amdgcn_fence(__ATOMIC_RELEASE, "agent");
            asm volatile("s_waitcnt vmcnt(0)" ::: "memory");
            const unsigned og = xb_add(&bar[XB_TOP], 1u);
            const unsigned tg = og / nx;
            if (og + 1u == (tg + 1u) * nx) xb_add(&bar[XB_TOPGEN], 1u);
            else XB_SPIN(xb_ld(&bar[XB_TOPGEN]) == tg, bar);
            __builtin_amdgcn_fence(__ATOMIC_ACQUIRE, "agent");
            xb_add(&bar[XB_XGEN(b.x)], 1u);
            asm volatile("s_waitcnt vmcnt(0)" ::: "memory");
        } else {
            XB_SPIN(xb_ld(&bar[XB_XGEN(b.x)]) == gen, bar);
            __builtin_amdgcn_fence(__ATOMIC_ACQUIRE, "agent");
            asm volatile("s_waitcnt vmcnt(0)" ::: "memory");
        }
    }
    __syncthreads();
}
struct Args { const float* in[18]; float* out; unsigned char* ws; int ph_lo, ph_hi; };
enum { I_X = 0, I_C, I_WADA, I_BADA, I_NMG, I_WIN, I_QG, I_KG, I_CONVW, I_CONVB, I_GATEB, I_MNG, I_WOUT, I_NFG, I_WGATE, I_WUP, I_WDOWN, I_FNG };

__device__ __forceinline__ float wave_sum(float v) {
#pragma unroll
    for (int o = 1; o < 64; o <<= 1) v += __shfl_xor(v, o);
    return v;
}
__device__ __forceinline__ float bf2f(bf16 h) { return __builtin_bit_cast(float, (unsigned)h << 16); }
__device__ __forceinline__ float bflo(unsigned w) { return __builtin_bit_cast(float, w << 16); }
__device__ __forceinline__ float bfhi(unsigned w) { return __builtin_bit_cast(float, w & 0xffff0000u); }

__device__ __forceinline__ int colmap_in(int j) {
    const int pn = j >> 8, jj = j & 255, bj = jj >> 7, wc = (jj >> 5) & 3, n = (jj >> 4) & 1, fq = (jj >> 2) & 3, e = jj & 3;
    return (pn <= 2) ? 256 * pn + 64 * wc + 16 * (2 * bj + n) + 4 * fq + e : 256 * pn + 128 * bj + 32 * wc + 8 * fq + 4 * n + e;
}
__device__ __forceinline__ int colmap_gu(int j) {
    const int pn = j >> 8, jj = j & 255, wc = (jj >> 5) & 3, n = (jj >> 4) & 1, fq = (jj >> 2) & 3, e = jj & 3;
    return 128 * pn + 32 * wc + 8 * fq + 4 * n + e;
}
__device__ __forceinline__ void transpose_item(const float* W, int ldw, int K, bf16* WT, int n0, int k0, int srccol, LAS float* scr, int lane) {
#pragma unroll 8
    for (int i = 0; i < 32; ++i) { const int kk = 2 * i + (lane >> 5); scr[kk * 33 + (lane & 31)] = W[(size_t)(k0 + kk) * ldw + srccol]; }
    LDS_WAIT(); asm volatile("" ::: "memory");
    const int c = lane & 7;
#pragma unroll
    for (int j = 0; j < 4; ++j) { const int n = (lane >> 3) + 8 * j; const LAS float* s = scr + (8 * c) * 33 + n;
        v4u o; o.x = pk2(s[0 * 33], s[1 * 33]); o.y = pk2(s[2 * 33], s[3 * 33]); o.z = pk2(s[4 * 33], s[5 * 33]); o.w = pk2(s[6 * 33], s[7 * 33]);
        *(GAS v4u*)(WT + (size_t)(n0 + n) * K + k0 + 8 * c) = o; }
    LDS_WAIT(); asm volatile("" ::: "memory");
}

__device__ __forceinline__ void p0_prologue(const Args& A, LAS unsigned char* lds, int tid, int lane, int wave, int vcu, int G) {
    unsigned char* ws = A.ws;
    LAS float* sc = (LAS float*)(lds + 73728);
    for (int i = tid; i < 8192; i += NTHREADS) { const int b = i >> 10, k = i & 1023; const float cv = A.in[I_C][i]; sc[k * 8 + b] = cv / (1.0f + expf(-cv)); }
    __syncthreads();
    LAS float* scr = (LAS float*)(lds + wave * 9216);
    const int gw = vcu * NWAVES + wave, NGW = G * NWAVES;
    constexpr int I_MOD = 96 * 8, T_IN = 16 * 88, T_OUT = 16 * 32, T_GU = 16 * 176, T_DN = 44 * 32;
    constexpr int NITEMS = I_MOD + T_IN + T_OUT + T_GU + T_DN;
    float* mod = (float*)(ws + WS_MOD);
    for (int it = gw; it < NITEMS; it += NGW) {
        int r = it;
        if (r < I_MOD) {
            const int cg = r >> 3, ks = r & 7, col = cg * 64 + lane; const float* w = A.in[I_WADA] + (size_t)(ks * 128) * NMOD + col;
            float acc[8];
#pragma unroll
            for (int b = 0; b < 8; ++b) acc[b] = 0.f;
#pragma unroll 8
            for (int kk = 0; kk < 128; ++kk) { const float wv = w[(size_t)kk * NMOD]; const f32x4 s0 = *(const LAS f32x4*)(sc + (ks * 128 + kk) * 8), s1 = *(const LAS f32x4*)(sc + (ks * 128 + kk) * 8 + 4);
                acc[0] += s0[0] * wv; acc[1] += s0[1] * wv; acc[2] += s0[2] * wv; acc[3] += s0[3] * wv; acc[4] += s1[0] * wv; acc[5] += s1[1] * wv; acc[6] += s1[2] * wv; acc[7] += s1[3] * wv; }
            const float bias = (ks == 0) ? A.in[I_BADA][col] : 0.f;
#pragma unroll
            for (int b = 0; b < 8; ++b) atomicAdd(mod + b * NMOD + col, acc[b] + bias);
            continue;
        }
        r -= I_MOD;
        if (r < T_IN) { const int kb = r / 88, nb = r % 88; transpose_item(A.in[I_WIN], NIN, DMODEL, (bf16*)(ws + WS_WIN), 32 * nb, 64 * kb, colmap_in(32 * nb + (lane & 31)), scr, lane); continue; }
        r -= T_IN;
        if (r < T_OUT) { const int kb = r / 32, nb = r % 32; transpose_item(A.in[I_WOUT], DMODEL, DMODEL, (bf16*)(ws + WS_WO), 32 * nb, 64 * kb, 32 * nb + (lane & 31), scr, lane); continue; }
        r -= T_OUT;
        if (r < T_GU) { const int kb = r / 176, nb = r % 176; const int j0 = 32 * nb; const float* W = ((j0 >> 7) & 1) ? A.in[I_WUP] : A.in[I_WGATE];
            transpose_item(W, FFH, DMODEL, (bf16*)(ws + WS_WGU), j0, 64 * kb, colmap_gu(j0 + (lane & 31)), scr, lane); continue; }
        r -= T_GU;
        { const int kb = r / 32, nb = r % 32; transpose_item(A.in[I_WDOWN], DMODEL, FFH, (bf16*)(ws + WS_WD), 32 * nb, 64 * kb, 32 * nb + (lane & 31), scr, lane); }
    }
    if (blockIdx.x == 0) {
        for (int i = tid; i < 1024; i += NTHREADS) { const int pos = i >> 4, f = i & 15; const float inv = powf(10000.0f, -(float)(2 * f) / 32.0f); const float ang = (float)pos * inv;
            ((float*)(ws + WS_TABC))[i] = cosf(ang); ((float*)(ws + WS_TABS))[i] = sinf(ang); }
        if (tid < 128) ((float*)(ws + WS_QKG))[tid] = (tid < 64) ? A.in[I_QG][tid] : A.in[I_KG][tid - 64];
    }
    if (blockIdx.x == 1 % G) {
        for (int i = tid; i < 16 * 1024; i += NTHREADS) { const int gi = i >> 10, k = i & 1023; ((bf16*)(ws + WS_WGT))[i] = (bf16)f2bf(A.in[I_WIN][(size_t)k * NIN + NPROJ + gi]); }
    }
}

template <int MODE> __device__ __forceinline__ void row_pass(const Args& A, int lane, int gw, int NGW) {
    const float* src = (MODE == 0) ? A.in[I_X] : A.out; const float* g = (MODE == 0) ? A.in[I_NMG] : (MODE == 1) ? A.in[I_NFG] : A.in[I_FNG];
    const float* mod = (const float*)(A.ws + WS_MOD); bf16* XN = (bf16*)(A.ws + WS_XN);
    for (int rg = gw; rg < M / 16; rg += NGW) {
        const int b = (rg * 16) >> 12; f32x4 gp[4], sh[4];
#pragma unroll
        for (int j = 0; j < 4; ++j) { const int col = 4 * lane + 256 * j; gp[j] = *(const f32x4*)(g + col);
            if (MODE < 2) { const int o = (MODE == 0) ? 0 : 3072; const f32x4 s = *(const f32x4*)(mod + b * NMOD + o + 1024 + col); gp[j] = gp[j] * (s + 1.0f); sh[j] = *(const f32x4*)(mod + b * NMOD + o + col); } }
        for (int i = 0; i < 16; ++i) {
            const size_t row = (size_t)rg * 16 + i; const f32x4* xr = (const f32x4*)(src + row * DMODEL) + lane;
            f32x4 v[4]; float s = 0.f;
#pragma unroll
            for (int j = 0; j < 4; ++j) { v[j] = xr[64 * j]; s += (v[j][0] * v[j][0] + v[j][1] * v[j][1]) + (v[j][2] * v[j][2] + v[j][3] * v[j][3]); }
            const float rstd = 1.0f / sqrtf(wave_sum(s) * (1.0f / DMODEL) + EPS);
            if (MODE < 2) {
                unsigned long long* o8 = (unsigned long long*)(XN + row * DMODEL) + lane;
#pragma unroll
                for (int j = 0; j < 4; ++j) { const f32x4 y = v[j] * rstd * gp[j] + sh[j]; o8[64 * j] = (unsigned long long)pk2(y[0], y[1]) | ((unsigned long long)pk2(y[2], y[3]) << 32); }
            } else {
                f32x4* o = (f32x4*)(A.out + row * DMODEL) + lane;
#pragma unroll
                for (int j = 0; j < 4; ++j) o[64 * j] = v[j] * rstd * gp[j];
            }
        }
    }
}
__device__ __forceinline__ void gates_pass(const Args& A, int lane, int gw, int NGW) {
    const bf16* XN = (const bf16*)(A.ws + WS_XN); const bf16* WgT = (const bf16*)(A.ws + WS_WGT); float* GT = (float*)(A.ws + WS_GATES);
    const int fr = lane & 15, fq = lane >> 4; const f32x4 gb = *(const f32x4*)(A.in[I_GATEB] + 4 * fq);
    for (int rg = gw; rg < M / 16; rg += NGW) {
        f32x4 acc = {0.f, 0.f, 0.f, 0.f}; const bf16* ap = XN + ((size_t)rg * 16 + fr) * DMODEL + 8 * fq; const bf16* bp = WgT + (size_t)fr * DMODEL + 8 * fq;
#pragma unroll 4
        for (int k0 = 0; k0 < DMODEL; k0 += 32) acc = __builtin_amdgcn_mfma_f32_16x16x32_bf16(*(const bf16x8*)(bp + k0), *(const bf16x8*)(ap + k0), acc, 0, 0, 0);
        *(f32x4*)(GT + ((size_t)rg * 16 + fr) * 16 + 4 * fq) = acc + gb;
    }
}
__device__ __forceinline__ void attn_naive_item(const bf16* Q, const bf16* K, const bf16* V, bf16* Y, int item, int tid) {
    const int b = item >> 6, h = (item >> 3) & 7, seg = item & 7, kvh = h >> 2;
    const size_t row = (size_t)b * SEQ + seg * 512 + tid;
    float q[64], o[64];
    { const v4u* qp = (const v4u*)(Q + row * 512 + h * 64);
#pragma unroll
      for (int i = 0; i < 8; ++i) { const v4u w = qp[i]; q[8 * i] = bflo(w.x); q[8 * i + 1] = bfhi(w.x); q[8 * i + 2] = bflo(w.y); q[8 * i + 3] = bfhi(w.y); q[8 * i + 4] = bflo(w.z); q[8 * i + 5] = bfhi(w.z); q[8 * i + 6] = bflo(w.w); q[8 * i + 7] = bfhi(w.w); } }
#pragma unroll
    for (int d = 0; d < 64; ++d) o[d] = 0.f;
    float m = -1e30f, l = 0.f;
    int z = 0; asm volatile("" : "+v"(z));
    const bf16* Kp = K + (size_t)b * SEQ * 128 + kvh * 64 + z; const bf16* Vp = V + (size_t)b * SEQ * 128 + kvh * 64 + z;
    for (int s = 0; s < SEQ; ++s) {
        const v4u* kr = (const v4u*)(Kp + (size_t)s * 128); float dot = 0.f;
#pragma unroll
        for (int i = 0; i < 8; ++i) { const v4u w = kr[i]; dot += q[8 * i] * bflo(w.x) + q[8 * i + 1] * bfhi(w.x) + q[8 * i + 2] * bflo(w.y) + q[8 * i + 3] * bfhi(w.y) + q[8 * i + 4] * bflo(w.z) + q[8 * i + 5] * bfhi(w.z) + q[8 * i + 6] * bflo(w.w) + q[8 * i + 7] * bfhi(w.w); }
        const float mn = fmaxf(m, dot), corr = exp2f(m - mn), p = exp2f(dot - mn); l = l * corr + p; m = mn;
        const v4u* vr = (const v4u*)(Vp + (size_t)s * 128);
#pragma unroll
        for (int i = 0; i < 8; ++i) { const v4u w = vr[i];
            o[8 * i] = o[8 * i] * corr + p * bflo(w.x); o[8 * i + 1] = o[8 * i + 1] * corr + p * bfhi(w.x); o[8 * i + 2] = o[8 * i + 2] * corr + p * bflo(w.y); o[8 * i + 3] = o[8 * i + 3] * corr + p * bfhi(w.y);
            o[8 * i + 4] = o[8 * i + 4] * corr + p * bflo(w.z); o[8 * i + 5] = o[8 * i + 5] * corr + p * bfhi(w.z); o[8 * i + 6] = o[8 * i + 6] * corr + p * bflo(w.w); o[8 * i + 7] = o[8 * i + 7] * corr + p * bfhi(w.w); }
    }
    const float inv = 1.0f / l; v4u* yp = (v4u*)(Y + row * 1024 + h * 64);
#pragma unroll
    for (int i = 0; i < 8; ++i) { v4u w; w.x = pk2(o[8 * i] * inv, o[8 * i + 1] * inv); w.y = pk2(o[8 * i + 2] * inv, o[8 * i + 3] * inv); w.z = pk2(o[8 * i + 4] * inv, o[8 * i + 5] * inv); w.w = pk2(o[8 * i + 6] * inv, o[8 * i + 7] * inv); yp[i] = w; }
}
__device__ __forceinline__ void mlstm_naive_item(const Args& A, int item, LAS float* lds, int tid) {
    const int b = item >> 3, h = (item >> 1) & 3, dir = item & 1, v = tid >> 2, dq = tid & 3;
    const bf16* QKM = (const bf16*)(A.ws + WS_QKM); const bf16* VM = (const bf16*)(A.ws + WS_VM); const float* GT = (const float*)(A.ws + WS_GATES);
    float* HF = (float*)(A.ws + WS_HF) + (size_t)dir * M * 512; const float* cw = A.in[I_CONVW]; const float* cb = A.in[I_CONVB];
    LAS float* qs = lds; LAS float* ks = lds + 32 * 128; LAS float* vs = lds + 2 * 32 * 128; LAS float* gi = lds + 3 * 32 * 128; LAS float* gf = gi + 32;
    float C[32], n[32]; float m = 0.f;
#pragma unroll
    for (int i = 0; i < 32; ++i) { C[i] = 0.f; n[i] = 0.f; }
    for (int blk = 0; blk < SEQ / 32; ++blk) {
        for (int idx = tid; idx < 32 * 256; idx += NTHREADS) { const int tt = idx >> 8, c = idx & 255, p = blk * 32 + tt, pos = dir ? SEQ - 1 - p : p;
            const int ch = (c < 128) ? h * 128 + c : 512 + h * 128 + (c - 128); float a = cb[ch];
#pragma unroll
            for (int j = 0; j < 5; ++j) { const int pp = pos - 2 + j; if (pp >= 0 && pp < SEQ) a += cw[j * 1024 + ch] * bf2f(QKM[((size_t)b * SEQ + pp) * 1024 + ch]); }
            const float sv = a / (1.0f + expf(-a));
            if (c < 128) qs[tt * 128 + c] = sv; else ks[tt * 128 + c - 128] = sv * 0.08838834764831845f; }
        for (int idx = tid; idx < 32 * 128; idx += NTHREADS) { const int tt = idx >> 7, c = idx & 127, p = blk * 32 + tt, pos = dir ? SEQ - 1 - p : p; vs[tt * 128 + c] = bf2f(VM[((size_t)b * SEQ + pos) * 512 + h * 128 + c]); }
        if (tid < 32) { const int p = blk * 32 + tid, pos = dir ? SEQ - 1 - p : p; const float* gp = GT + ((size_t)b * SEQ + pos) * 16; gi[tid] = gp[dir * 8 + h]; const float f = gp[dir * 8 + 4 + h]; gf[tid] = fminf(f, 0.f) - log1pf(expf(-fabsf(f))); }
        __syncthreads();
        for (int tt = 0; tt < 32; ++tt) {
            const float it = gi[tt], lf = gf[tt], mn = fmaxf(lf + m, it), fg = expf(lf + m - mn), ig = expf(it - mn); m = mn;
            const float vv = vs[tt * 128 + v] * ig; float num = 0.f, den = 0.f;
#pragma unroll
            for (int i4 = 0; i4 < 8; ++i4) { const f32x4 kd = *(const LAS f32x4*)(ks + tt * 128 + dq * 32 + 4 * i4), qd = *(const LAS f32x4*)(qs + tt * 128 + dq * 32 + 4 * i4);
#pragma unroll
                for (int e = 0; e < 4; ++e) { const int i = 4 * i4 + e; C[i] = fg * C[i] + vv * kd[e]; n[i] = fg * n[i] + ig * kd[e]; num += C[i] * qd[e]; den += n[i] * qd[e]; } }
            num += __shfl_xor(num, 1); num += __shfl_xor(num, 2); den += __shfl_xor(den, 1); den += __shfl_xor(den, 2);
            if (dq == 0) { const int p = blk * 32 + tt, pos = dir ? SEQ - 1 - p : p; HF[((size_t)b * SEQ + pos) * 512 + h * 128 + v] = num / fmaxf(fabsf(den), expf(-mn)); }
        }
        __syncthreads();
    }
}
__device__ __forceinline__ void finalize_pass(const Args& A, int lane, int gw, int NGW) {
    const float* H0 = (const float*)(A.ws + WS_HF); const float* H1 = H0 + (size_t)M * 512; const bf16* OM = (const bf16*)(A.ws + WS_OM); bf16* Y = (bf16*)(A.ws + WS_Y);
    const f32x4 g0 = *(const f32x4*)(A.in[I_MNG] + 8 * lane), g1 = *(const f32x4*)(A.in[I_MNG] + 8 * lane + 4);
    for (int row = gw; row < M; row += NGW) {
        const f32x4 a0 = *(const f32x4*)(H0 + (size_t)row * 512 + 8 * lane), a1 = *(const f32x4*)(H0 + (size_t)row * 512 + 8 * lane + 4);
        const f32x4 b0 = *(const f32x4*)(H1 + (size_t)row * 512 + 8 * lane), b1 = *(const f32x4*)(H1 + (size_t)row * 512 + 8 * lane + 4);
        const f32x4 h0 = a0 + b0, h1 = a1 + b1;
        float ss = (h0[0] * h0[0] + h0[1] * h0[1]) + (h0[2] * h0[2] + h0[3] * h0[3]) + (h1[0] * h1[0] + h1[1] * h1[1]) + (h1[2] * h1[2] + h1[3] * h1[3]);
        ss += __shfl_xor(ss, 1); ss += __shfl_xor(ss, 2); ss += __shfl_xor(ss, 4); ss += __shfl_xor(ss, 8);
        const float rstd = 1.0f / sqrtf(ss * (1.0f / 128.0f) + EPS);
        const v4u ow = *(const v4u*)(OM + (size_t)row * 512 + 8 * lane);
        const float og[8] = {bflo(ow.x), bfhi(ow.x), bflo(ow.y), bfhi(ow.y), bflo(ow.z), bfhi(ow.z), bflo(ow.w), bfhi(ow.w)};
        float y[8];
#pragma unroll
        for (int e = 0; e < 4; ++e) { y[e] = h0[e] * rstd * g0[e] / (1.0f + expf(-og[e])); y[4 + e] = h1[e] * rstd * g1[e] / (1.0f + expf(-og[4 + e])); }
        v4u w; w.x = pk2(y[0], y[1]); w.y = pk2(y[2], y[3]); w.z = pk2(y[4], y[5]); w.w = pk2(y[6], y[7]);
        *(v4u*)(Y + (size_t)row * 1024 + 512 + 8 * lane) = w;
    }
}

__global__ void __launch_bounds__(NTHREADS, 2) hymba_fwd(Args args) {
    extern __shared__ __attribute__((aligned(16))) unsigned char lds_raw[];
    LAS unsigned char* lds = (LAS unsigned char*)lds_raw;
    volatile LAS unsigned* MISC = (volatile LAS unsigned*)(lds + MISC_OFF);
    const int tid = threadIdx.x, lane = tid & 63, wave = __builtin_amdgcn_readfirstlane(tid >> 6);
    const int G = gridDim.x, bx = blockIdx.x, vcu = (G % 8 == 0) ? (bx % 8) * (G / 8) + bx / 8 : bx;
    const int gw = vcu * NWAVES + wave, NGW = G * NWAVES;
    unsigned char* ws = args.ws; gu32* ctl = (gu32*)(ws + WS_CTL);
    for (int u = tid; u < (LDS_BYTES - LDSCTL_OFF) / 4; u += NTHREADS) ((LAS unsigned*)(lds + LDSCTL_OFF))[u] = 0u;
    __syncthreads();
    XcdBarrier bar; bar.bar = (unsigned*)(ctl + CW_BAR); bar.x = 0; bar.st = nullptr;
    if (N_LAUNCHES == 1) bar = xcd_barrier_post((unsigned*)(ctl + CW_BAR), MISC + 8);
#define GRID_BAR() do { if (N_LAUNCHES == 1) xcd_barrier(bar); } while (0)
    const int lo = args.ph_lo, hi = args.ph_hi;
#define IN(k) (lo <= (k) && (k) < hi)
#define BOTH(k) (IN(k) && IN((k) + 1))
    bf16* XN = (bf16*)(ws + WS_XN); float* mod = (float*)(ws + WS_MOD);

    if (IN(0)) { p0_prologue(args, lds, tid, lane, wave, vcu, G); if (BOTH(0)) GRID_BAR(); }
    if (IN(1)) { row_pass<0>(args, lane, gw, NGW); if (BOTH(1)) GRID_BAR(); }
    if (IN(2)) {
        gates_pass(args, lane, gw, NGW);
        pg8::Gemm g{XN, (const bf16*)(ws + WS_WIN), M, NPROJ, DMODEL}; pg8::StaticOrder S; S.init(M, NPROJ, G, bx);
        pg8::EpiInProj E{ws};
#if NAIVE_GEMM
        pg8::gemm_simple<pg8::EpiInProj, pg8::StaticOrder>(g, S, E);
#else
        pg8::gemm_phase<pg8::EpiInProj, pg8::StaticOrder, PG8_ALIGN, PG8_SP2>(lds, g, S, E);
#endif
        if (BOTH(2)) GRID_BAR();
    }
    if (IN(3)) {
        for (int it = bx; it < 64; it += G) mlstm_naive_item(args, it, (LAS float*)lds, tid);
#if NAIVE_ATTN
        for (int it = bx; it < 512; it += G) attn_naive_item((const bf16*)(ws + WS_Q), (const bf16*)(ws + WS_K), (const bf16*)(ws + WS_V), (bf16*)(ws + WS_Y), it, tid);
#else
        { const attn_body::AttnTensors AT{(const attn_body::bf16*)(ws + WS_Q), (const attn_body::bf16*)(ws + WS_K), (const attn_body::bf16*)(ws + WS_V), (attn_body::bf16*)(ws + WS_Y)};
          const attn_body::StaticOrder S(G, bx); attn_body::attn_phase<attn_body::StaticOrder>((char*)lds_raw, AT, S); }
#endif
        if (BOTH(3)) GRID_BAR();
    }
    if (IN(4)) { finalize_pass(args, lane, gw, NGW); if (BOTH(4)) GRID_BAR(); }
    if (IN(5)) {
        pg8::Gemm g{(const bf16*)(ws + WS_Y), (const bf16*)(ws + WS_WO), M, DMODEL, DMODEL}; pg8::StaticOrder S; S.init(M, DMODEL, G, bx);
        pg8::EpiResGate E{args.in[I_X], args.out, mod + 2048};
#if NAIVE_GEMM
        pg8::gemm_simple<pg8::EpiResGate, pg8::StaticOrder>(g, S, E);
#else
        pg8::gemm_phase<pg8::EpiResGate, pg8::StaticOrder, PG8_ALIGN, PG8_SP2>(lds, g, S, E);
#endif
        if (BOTH(5)) GRID_BAR();
    }
    if (IN(6)) { row_pass<1>(args, lane, gw, NGW); if (BOTH(6)) GRID_BAR(); }
    if (IN(7)) {
        pg8::Gemm g{XN, (const bf16*)(ws + WS_WGU), M, 2 * FFH, DMODEL}; pg8::StaticOrder S; S.init(M, 2 * FFH, G, bx);
        pg8::EpiSwiGLU E{(bf16*)(ws + WS_ACT)};
#if NAIVE_GEMM
        pg8::gemm_simple<pg8::EpiSwiGLU, pg8::StaticOrder>(g, S, E);
#else
        pg8::gemm_phase<pg8::EpiSwiGLU, pg8::StaticOrder, PG8_ALIGN, PG8_SP2>(lds, g, S, E);
#endif
        if (BOTH(7)) GRID_BAR();
    }
    if (IN(8)) {
        pg8::Gemm g{(const bf16*)(ws + WS_ACT), (const bf16*)(ws + WS_WD), M, DMODEL, FFH}; pg8::StaticOrder S; S.init(M, DMODEL, G, bx);
        pg8::EpiResGate E{args.out, args.out, mod + 5120};
#if NAIVE_GEMM
        pg8::gemm_simple<pg8::EpiResGate, pg8::StaticOrder>(g, S, E);
#else
        pg8::gemm_phase<pg8::EpiResGate, pg8::StaticOrder, PG8_ALIGN, PG8_SP2>(lds, g, S, E);
#endif
        if (BOTH(8)) GRID_BAR();
    }
    if (IN(9)) { row_pass<2>(args, lane, gw, NGW); }
#undef IN
#undef BOTH
}

extern "C" void kernel_launch(void* const* d_in, const int* in_sizes, int n_in, void* d_out, int out_size, void* d_ws, size_t ws_size, hipStream_t stream) {
    static int grid = 0;
    if (grid == 0) {
        if (n_in != 18 || in_sizes[0] != M * DMODEL || out_size != M * DMODEL || ws_size < WS_END) { fprintf(stderr, "kernel_launch: unexpected shapes (n_in %d, in0 %d, out %d, ws %zu < %zu)\n", n_in, n_in > 0 ? in_sizes[0] : -1, out_size, ws_size, (size_t)WS_END); grid = -1; return; }
        int dev = 0, cus = 0, per_cu = 0;
        if (hipGetDevice(&dev) != hipSuccess || hipDeviceGetAttribute(&cus, hipDeviceAttributeMultiprocessorCount, dev) != hipSuccess) { grid = -1; return; }
        if (hipFuncSetAttribute((const void*)hymba_fwd, hipFuncAttributeMaxDynamicSharedMemorySize, LDS_BYTES) != hipSuccess) { fprintf(stderr, "kernel_launch: hipFuncSetAttribute failed\n"); grid = -1; return; }
        if (hipOccupancyMaxActiveBlocksPerMultiprocessor(&per_cu, (const void*)hymba_fwd, NTHREADS, LDS_BYTES) != hipSuccess || per_cu < 1) { fprintf(stderr, "kernel_launch: occupancy query says %d blocks per CU\n", per_cu); (void)hipGetLastError(); grid = -1; return; }
        grid = cus;
    }
    if (grid < 0) return;
    if (hipMemsetAsync((char*)d_ws + WS_CTL, 0, CTL_ZERO_BYTES, stream) != hipSuccess) return;
    Args a{};
    for (int i = 0; i < 18; ++i) a.in[i] = (const float*)d_in[i];
    a.out = (float*)d_out; a.ws = (unsigned char*)d_ws;
    if (N_LAUNCHES == 1) { a.ph_lo = 0; a.ph_hi = NPHASE; hipLaunchKernelGGL(hymba_fwd, dim3(grid), dim3(NTHREADS), LDS_BYTES, stream, a); }
    else for (int p = 0; p < NPHASE; ++p) { a.ph_lo = p; a.ph_hi = p + 1; hipLaunchKernelGGL(hymba_fwd, dim3(grid), dim3(NTHREADS), LDS_BYTES, stream, a); }
}
```

```cpp
#include <hip/hip_runtime.h>
#include <hip/hip_bf16.h>
#include <cstdio>
#include <cstdint>
#include <cmath>
#ifndef NAIVE_GEMM
#define NAIVE_GEMM 0
#endif
#ifndef NAIVE_ATTN
#define NAIVE_ATTN 0
#endif
#ifndef NAIVE_MLSTM
#define NAIVE_MLSTM 0
#endif
#ifndef MK_N_LAUNCHES
#define MK_N_LAUNCHES 1
#endif
constexpr int NWAVES = 8, NTHREADS = NWAVES * 64;
constexpr int BATCH = 8, SEQ = 4096, DMODEL = 1024, M = BATCH * SEQ;
constexpr int NPROJ = 2816, NIN = 2832, FFH = 2816, NMOD = 6144;
constexpr float EPS = 1e-6f;
constexpr int N_LAUNCHES = MK_N_LAUNCHES;
constexpr int NPHASE = 11;
constexpr size_t MiB = 1u << 20;
constexpr size_t WS_CTL = 0, CTL_ZERO_BYTES = 1 * MiB;
constexpr int CW_TMO = 0, CW_CODE = 1, CW_BAR = 4096, CW_QUEUE = 8192;
constexpr size_t WS_MOD = 512 * 1024;
constexpr size_t WS_TABC = 1 * MiB, WS_TABS = 1 * MiB + 4096, WS_QKG = 1 * MiB + 8192, WS_WGT = 1 * MiB + 65536;
constexpr size_t WS_WIN = 2 * MiB, WS_WO = 8 * MiB, WS_WGU = 10 * MiB, WS_WD = 22 * MiB;
constexpr size_t WS_XN = 32 * MiB, WS_Q = 96 * MiB, WS_K = 128 * MiB, WS_V = 136 * MiB, WS_QKM = 144 * MiB, WS_VM = 208 * MiB, WS_OM = 240 * MiB;
constexpr size_t WS_GATES = 272 * MiB, WS_Y = 276 * MiB, WS_HF = 340 * MiB, WS_VF = 468 * MiB, WS_END = 500 * MiB;
constexpr size_t WS_QC = 32 * MiB, WS_KC = 64 * MiB;
constexpr size_t WS_ACT = 96 * MiB;
static_assert(WS_ACT + (size_t)M * FFH * 2 <= WS_GATES, "ACT overlay");
constexpr int RING_BYTES = 131072, LDS_BYTES = 163840, LDSCTL_OFF = LDS_BYTES - 1024, MISC_OFF = LDSCTL_OFF + 320;
#ifdef XB_SPIN_CAP
#undef XB_SPIN_CAP
#endif
#define XB_SPIN_CAP (1u << 26)

namespace pg8 {
#define PG8_LAS __attribute__((address_space(3)))
typedef unsigned short bf16_t;
typedef short bf16x8 __attribute__((ext_vector_type(8)));
typedef float f32x4 __attribute__((ext_vector_type(4)));
typedef unsigned u32x4 __attribute__((ext_vector_type(4)));
constexpr int BM = 256, BK = 64, HALF = 128, HTB = HALF * BK * 2  , STAGE_BYTES = 8 * HTB, NXCD = 8, WGM = 8;

__host__ __device__ __forceinline__ int lds_byte(int r, int c) { const int st = (r >> 4) * 2 + (c >> 5), rr = r & 15, cc = c & 31, ob = rr * 64 + cc * 2; return st * 1024 + (ob ^ (((ob >> 9) & 1) << 5)); }
__host__ __device__ __forceinline__ void stage_rc(int b, int& R, int& C) { const int st = b / 1024, sb = b % 1024, swz = sb ^ (((sb >> 9) & 1) << 5); R = (st >> 1) * 16 + swz / 64; C = (st & 1) * 32 + (swz % 64) / 2; }
__host__ __device__ __forceinline__ int perm32(int rho) { const int n = rho >> 4, i = rho & 15; return 8 * (i >> 2) + 4 * n + (i & 3); }

struct Unit { int pm, pn; };
struct Gemm { const bf16_t* A; const bf16_t* Bt; int M, N, K; };

struct StaticOrder {
    int nM, nN, nwg, G, c;
    __host__ __device__ void init(int M, int N, int G_, int c_) { nM = M / BM; nN = N / BM; nwg = nM * nN; G = G_; c = c_; }
    __host__ __device__ bool next(int i, Unit& u) const {
        const long L = (long)i * G + c; if (L >= nwg) return false;
        int wgid = (int)L; { const int q = nwg / NXCD, r = nwg % NXCD, xcd = wgid % NXCD, off = wgid / NXCD; wgid = (xcd < r ? xcd * (q + 1) : r * (q + 1) + (xcd - r) * q) + off; }
        const int nig = WGM * nN, gid = wgid / nig, fm = gid * WGM, gsz = (nM - fm) < WGM ? (nM - fm) : WGM;
        u.pm = fm + ((wgid % nig) % gsz); u.pn = (wgid % nig) / gsz; return true;
    }
    __device__ __forceinline__ void a_ready(const Unit&) const {}
    __device__ __forceinline__ void done(const Unit&) const {}
};

__device__ __forceinline__ unsigned cvt_pk_bf16(float lo, float hi) { unsigned r; asm volatile("v_cvt_pk_bf16_f32 %0, %1, %2" : "=v"(r) : "v"(lo), "v"(hi)); return r; }
typedef float f32x2 __attribute__((ext_vector_type(2)));
template <class Epi, class Sched, bool ALIGN_EPI = false, bool SP2 = false>
__device__ __forceinline__ void gemm_phase(PG8_LAS unsigned char* lds, const Gemm g, const Sched& S, const Epi& E) {
    const int tid = threadIdx.x, wid = __builtin_amdgcn_readfirstlane(tid >> 6), lane = tid & 63, wr = wid >> 2, wc = wid & 3, fr = lane & 15, fq = lane >> 4;
    const int K = g.K, nt = K / BK;
    unsigned voffA[2], voffB[2];
#pragma unroll
    for (int i = 0; i < 2; ++i) { int R, C; stage_rc(tid * 16 + i * 8192, R, C); const int Rb = Epi::PERM ? ((R & ~31) + perm32(R & 31)) : R;
        voffA[i] = (unsigned)(R * K + C) * 2u; voffB[i] = (unsigned)(Rb * K + C) * 2u; }
    const size_t kstep = (size_t)(BK * 2);
    const size_t hstep = (size_t)HALF * K * 2;
    const size_t tstep = 2 * hstep;
    const unsigned ldsw = (unsigned)wid * 1024u;
    const int aoff = lds_byte(wr * 64 + fr, fq * 8), boff = lds_byte(wc * 32 + fr, fq * 8);
#define PG8_SA(b, h) (((b) * 2 + (h)) * HTB)
#define PG8_SB(b, h) ((4 + (b) * 2 + (h)) * HTB)
#define PG8_STAGE(bufoff, gbase, voff) do { _Pragma("unroll") for (int _i = 0; _i < 2; ++_i) \
        __builtin_amdgcn_global_load_lds((const unsigned*)((const char*)(gbase) + (voff)[_i]), (PG8_LAS unsigned*)(lds + (bufoff) + ldsw + _i * 8192), 16, 0, 0); } while (0)
#define PG8_LDA(dst, b, h) do { _Pragma("unroll") for (int m = 0; m < 4; ++m) _Pragma("unroll") for (int k = 0; k < 2; ++k) dst[m][k] = *(const PG8_LAS bf16x8*)(lds + PG8_SA(b, h) + aoff + m * 2048 + k * 1024); } while (0)
#define PG8_LDB(dst, b, h) do { _Pragma("unroll") for (int n = 0; n < 2; ++n) _Pragma("unroll") for (int k = 0; k < 2; ++k) dst[n][k] = *(const PG8_LAS bf16x8*)(lds + PG8_SB(b, h) + boff + n * 2048 + k * 1024); } while (0)
#define PG8_MMA(ai, bj, At, Bt) do { __builtin_amdgcn_s_setprio(1); _Pragma("unroll") for (int m = 0; m < 4; ++m) _Pragma("unroll") for (int n = 0; n < 2; ++n) _Pragma("unroll") for (int k = 0; k < 2; ++k) \
        acc[ai][bj][m][n] = __builtin_amdgcn_mfma_f32_16x16x32_bf16(Bt[n][k], At[m][k], acc[ai][bj][m][n], 0, 0, 0); __builtin_amdgcn_s_setprio(0); } while (0)
#define PG8_WAIT_V(n) asm volatile("s_waitcnt vmcnt(" #n ")" ::: "memory")
#define PG8_WAIT_L(n) asm volatile("s_waitcnt lgkmcnt(" #n ")" ::: "memory")
#define PG8_BAR __builtin_amdgcn_s_barrier()
#define PG8_SCHED __builtin_amdgcn_sched_barrier(0)
    Unit cur, nxt; int ui = 0;
    if (!S.next(0, cur)) return;
    f32x4 acc[2][2][4][2];
#pragma unroll
    for (int a = 0; a < 2; ++a)
#pragma unroll
        for (int b = 0; b < 2; ++b)
#pragma unroll
            for (int m = 0; m < 4; ++m)
#pragma unroll
                for (int n = 0; n < 2; ++n) acc[a][b][m][n] = (f32x4){0.f, 0.f, 0.f, 0.f};
    bf16x8 At[4][2], B0[2][2], B1[2][2];
    const char* cA = (const char*)g.A + (size_t)cur.pm * tstep; const char* cB = (const char*)g.Bt + (size_t)cur.pn * tstep;
    S.a_ready(cur);
    if constexpr (SP2) {
        PG8_STAGE(PG8_SB(0, 0), cB, voffB); PG8_STAGE(PG8_SB(0, 1), cB + hstep, voffB); PG8_STAGE(PG8_SA(0, 0), cA, voffA); PG8_STAGE(PG8_SA(0, 1), cA + hstep, voffA);
        if (wr == 1) PG8_BAR;
        PG8_WAIT_V(2); PG8_BAR;
        PG8_STAGE(PG8_SB(1, 0), cB + kstep, voffB); PG8_STAGE(PG8_SA(1, 0), cA + kstep, voffA); PG8_STAGE(PG8_SB(1, 1), cB + hstep + kstep, voffB);
        PG8_WAIT_V(6); PG8_BAR;
    } else {
        PG8_STAGE(PG8_SB(0, 0), cB, voffB); PG8_STAGE(PG8_SA(0, 0), cA, voffA); PG8_STAGE(PG8_SB(0, 1), cB + hstep, voffB); PG8_STAGE(PG8_SA(0, 1), cA + hstep, voffA);
        if (wr == 1) PG8_BAR;
        PG8_WAIT_V(4); PG8_BAR;
        PG8_STAGE(PG8_SB(1, 0), cB + kstep, voffB); PG8_STAGE(PG8_SA(1, 0), cA + kstep, voffA); PG8_STAGE(PG8_SB(1, 1), cB + hstep + kstep, voffB);
        PG8_WAIT_V(6); PG8_BAR;
    }
    for (;;) {
        const bool has_next = S.next(ui + 1, nxt);
        const char* nA = has_next ? (const char*)g.A + (size_t)nxt.pm * tstep : cA; const char* nB = has_next ? (const char*)g.Bt + (size_t)nxt.pn * tstep : cB;
        for (int t = 0; t < nt; t += 2) {
            const bool last = (t == nt - 2);
            const char* a1 = cA + (size_t)(t + 1) * kstep;
            const char* a2 = last ? nA : cA + (size_t)(t + 2) * kstep; const char* b2 = last ? nB : cB + (size_t)(t + 2) * kstep;
            const char* a3 = a2 + kstep; const char* b3 = b2 + kstep;
            if (last && has_next) S.a_ready(nxt);
            if constexpr (SP2) {
            PG8_LDB(B0, 0, 0); PG8_LDB(B1, 0, 1); PG8_SCHED; PG8_LDA(At, 0, 0); PG8_STAGE(PG8_SA(1, 1), a1 + hstep, voffA);
            PG8_WAIT_V(8); PG8_WAIT_L(0); PG8_BAR; PG8_MMA(0, 0, At, B0); PG8_MMA(0, 1, At, B1); PG8_BAR; PG8_SCHED;
            PG8_LDA(At, 0, 1); PG8_STAGE(PG8_SB(0, 0), b2, voffB); PG8_STAGE(PG8_SB(0, 1), b2 + hstep, voffB); PG8_STAGE(PG8_SA(0, 0), a2, voffA);
            PG8_WAIT_V(8); PG8_WAIT_L(0); PG8_BAR; PG8_MMA(1, 0, At, B0); PG8_MMA(1, 1, At, B1); PG8_BAR; PG8_SCHED;
            PG8_LDB(B0, 1, 0); PG8_LDB(B1, 1, 1); PG8_SCHED; PG8_LDA(At, 1, 0); PG8_STAGE(PG8_SA(0, 1), a2 + hstep, voffA);
            PG8_WAIT_V(8); PG8_WAIT_L(0); PG8_BAR; PG8_MMA(0, 0, At, B0); PG8_MMA(0, 1, At, B1); PG8_BAR; PG8_SCHED;
            PG8_LDA(At, 1, 1); PG8_STAGE(PG8_SB(1, 0), b3, voffB); PG8_STAGE(PG8_SB(1, 1), b3 + hstep, voffB); PG8_STAGE(PG8_SA(1, 0), a3, voffA);
            PG8_WAIT_V(8); PG8_WAIT_L(0); PG8_BAR; PG8_MMA(1, 0, At, B0); PG8_MMA(1, 1, At, B1); PG8_BAR; PG8_SCHED;
            } else {
            PG8_LDB(B0, 0, 0); PG8_SCHED; PG8_LDA(At, 0, 0); PG8_STAGE(PG8_SA(1, 1), a1 + hstep, voffA);
            PG8_WAIT_L(8); PG8_BAR; PG8_WAIT_L(0); PG8_MMA(0, 0, At, B0); PG8_BAR; PG8_SCHED;
            PG8_LDB(B1, 0, 1); PG8_STAGE(PG8_SB(0, 0), b2, voffB);
            PG8_BAR; PG8_WAIT_L(0); PG8_MMA(0, 1, At, B1); PG8_BAR;
            PG8_LDA(At, 0, 1); PG8_STAGE(PG8_SA(0, 0), a2, voffA);
            PG8_BAR; PG8_WAIT_L(0); PG8_MMA(1, 0, At, B0); PG8_BAR; PG8_SCHED;
            PG8_STAGE(PG8_SB(0, 1), b2 + hstep, voffB);
            PG8_WAIT_V(6); PG8_BAR; PG8_MMA(1, 1, At, B1); PG8_BAR;
            PG8_LDB(B0, 1, 0); PG8_SCHED; PG8_LDA(At, 1, 0); PG8_STAGE(PG8_SA(0, 1), a2 + hstep, voffA);
            PG8_WAIT_L(8); PG8_BAR; PG8_WAIT_L(0); PG8_MMA(0, 0, At, B0); PG8_BAR; PG8_SCHED;
            PG8_LDB(B1, 1, 1); PG8_STAGE(PG8_SB(1, 0), b3, voffB);
            PG8_BAR; PG8_WAIT_L(0); PG8_MMA(0, 1, At, B1); PG8_BAR;
            PG8_LDA(At, 1, 1); PG8_STAGE(PG8_SA(1, 0), a3, voffA);
            PG8_BAR; PG8_WAIT_L(0); PG8_MMA(1, 0, At, B0); PG8_BAR; PG8_SCHED;
            PG8_STAGE(PG8_SB(1, 1), b3 + hstep, voffB);
            PG8_WAIT_V(6); PG8_BAR; PG8_MMA(1, 1, At, B1); PG8_BAR;
            }
        }
        if constexpr (ALIGN_EPI) { if (wr == 0) PG8_BAR; }
        if constexpr (!Epi::AFTER_DRAIN) { E(acc, cur, wr, wc, fr, fq); S.done(cur); }
        if (!has_next) break;
#pragma unroll
        for (int a = 0; a < 2; ++a)
#pragma unroll
            for (int b = 0; b < 2; ++b)
#pragma unroll
                for (int m = 0; m < 4; ++m)
#pragma unroll
                    for (int n = 0; n < 2; ++n) acc[a][b][m][n] = (f32x4){0.f, 0.f, 0.f, 0.f};
        cur = nxt; cA = nA; cB = nB; ++ui;
        if constexpr (ALIGN_EPI) { if (wr == 1) PG8_BAR; }
    }
    PG8_WAIT_V(0);
    if constexpr (!ALIGN_EPI) { if (wr == 0) PG8_BAR; }
    PG8_BAR;
    if constexpr (Epi::AFTER_DRAIN) { E.fused(acc, cur, wr, wc, fr, fq, lds, wid, lane); S.done(cur); }
#undef PG8_SA
#undef PG8_SB
#undef PG8_STAGE
#undef PG8_LDA
#undef PG8_LDB
#undef PG8_MMA
#undef PG8_WAIT_V
#undef PG8_WAIT_L
#undef PG8_BAR
#undef PG8_SCHED
}
typedef unsigned u32x2 __attribute__((ext_vector_type(2)));
constexpr float ATT_C2 = 0.125f * 1.4426950408889634f;
struct EpiInProj {
    static constexpr bool PERM = false, AFTER_DRAIN = false;
    unsigned char* ws;
    __device__ __forceinline__ void operator()(const f32x4 (&acc)[2][2][4][2], const Unit& u, int wr, int wc, int fr, int fq) const {
        const int pn = u.pn, row0 = u.pm * BM + wr * 64 + fr;
        if (pn >= 3) {
            const size_t boff = (pn < 7) ? WS_QKM : ((pn < 9) ? WS_VM : WS_OM);
            const int ldc = (pn < 7) ? 1024 : 512, c0 = 256 * ((pn < 7) ? (pn - 3) : ((pn < 9) ? (pn - 7) : (pn - 9))) + wc * 32 + 8 * fq;
            bf16_t* base = (bf16_t*)(ws + boff);
#pragma unroll
            for (int ai = 0; ai < 2; ++ai)
#pragma unroll
                for (int m = 0; m < 4; ++m) { bf16_t* rowp = base + (size_t)(row0 + ai * HALF + m * 16) * ldc + c0;
#pragma unroll
                    for (int bj = 0; bj < 2; ++bj) { const f32x4 v0 = acc[ai][bj][m][0], v1 = acc[ai][bj][m][1]; u32x4 w;
                        w.x = cvt_pk_bf16(v0[0], v0[1]); w.y = cvt_pk_bf16(v0[2], v0[3]); w.z = cvt_pk_bf16(v1[0], v1[1]); w.w = cvt_pk_bf16(v1[2], v1[3]);
                        *(u32x4*)(rowp + bj * HALF) = w; } }
            return;
        }
        const bool isv = (pn == 2 && wc >= 2), isq = (pn < 2);
        const size_t boff = isq ? WS_Q : (isv ? WS_V : WS_K);
        const int ldc = isq ? 512 : 128, hcol = isq ? (4 * pn + wc) * 64 : (wc & 1) * 64;
        bf16_t* base = (bf16_t*)(ws + boff);
        const float* g = (const float*)(ws + WS_QKG) + (isq ? 0 : 64);
        const float* tabc = (const float*)(ws + WS_TABC); const float* tabs = (const float*)(ws + WS_TABS);
        f32x4 gv[4];
#pragma unroll
        for (int dq = 0; dq < 4; ++dq) gv[dq] = *(const f32x4*)(g + 16 * dq + 4 * fq);
        const float osc = isq ? ATT_C2 : 1.0f;
#pragma unroll
        for (int ai = 0; ai < 2; ++ai)
#pragma unroll
            for (int m = 0; m < 4; ++m) {
                const int r = row0 + ai * HALF + m * 16;
                f32x4 y[4];
#pragma unroll
                for (int dq = 0; dq < 4; ++dq) y[dq] = acc[ai][dq >> 1][m][dq & 1];
                if (!isv) {
                    float ss = 0.f;
#pragma unroll
                    for (int dq = 0; dq < 4; ++dq) ss += (y[dq][0] * y[dq][0] + y[dq][1] * y[dq][1]) + (y[dq][2] * y[dq][2] + y[dq][3] * y[dq][3]);
                    ss += __shfl_xor(ss, 16); ss += __shfl_xor(ss, 32);
                    const float rstd = 1.0f / sqrtf(ss * (1.0f / 64.0f) + 1e-6f);
#pragma unroll
                    for (int dq = 0; dq < 4; ++dq) y[dq] = y[dq] * rstd * gv[dq];
                    const int t = r & 4095, pr = t >> 6, pc = t & 63;
                    const f32x4 cr = *(const f32x4*)(tabc + pr * 16 + 4 * fq), sr = *(const f32x4*)(tabs + pr * 16 + 4 * fq);
                    const f32x4 cc = *(const f32x4*)(tabc + pc * 16 + 4 * fq), sc = *(const f32x4*)(tabs + pc * 16 + 4 * fq);
                    const f32x4 o0 = y[0] * cr - y[1] * sr, o1 = y[1] * cr + y[0] * sr, o2 = y[2] * cc - y[3] * sc, o3 = y[3] * cc + y[2] * sc;
                    y[0] = o0 * osc; y[1] = o1 * osc; y[2] = o2 * osc; y[3] = o3 * osc;
                }
                bf16_t* rowp = base + (size_t)r * ldc + hcol + 4 * fq;
#pragma unroll
                for (int dq = 0; dq < 4; ++dq) { u32x2 w; w.x = cvt_pk_bf16(y[dq][0], y[dq][1]); w.y = cvt_pk_bf16(y[dq][2], y[dq][3]); *(u32x2*)(rowp + 16 * dq) = w; }
            }
    }
};
struct EpiResGate {
    static constexpr bool PERM = false, AFTER_DRAIN = false;
    const float* base; float* out; const float* gate;
    __device__ __forceinline__ void operator()(const f32x4 (&acc)[2][2][4][2], const Unit& u, int wr, int wc, int fr, int fq) const {
        const int row0 = u.pm * BM + wr * 64 + fr, col0 = u.pn * BM + wc * 32 + 4 * fq, b = (u.pm * BM) >> 12;
        f32x4 gv[2][2];
#pragma unroll
        for (int bj = 0; bj < 2; ++bj)
#pragma unroll
            for (int n = 0; n < 2; ++n) gv[bj][n] = *(const f32x4*)(gate + (size_t)b * 6144 + col0 + bj * HALF + n * 16);
#pragma unroll
        for (int ai = 0; ai < 2; ++ai)
#pragma unroll
            for (int m = 0; m < 4; ++m) { const size_t off = (size_t)(row0 + ai * HALF + m * 16) * 1024 + col0;
#pragma unroll
                for (int bj = 0; bj < 2; ++bj)
#pragma unroll
                    for (int n = 0; n < 2; ++n) { const f32x4 bs = *(const f32x4*)(base + off + bj * HALF + n * 16); *(f32x4*)(out + off + bj * HALF + n * 16) = bs + gv[bj][n] * acc[ai][bj][m][n]; } }
    }
};
struct EpiSwiGLU {
    static constexpr bool PERM = false, AFTER_DRAIN = false;
    bf16_t* act;
    __device__ __forceinline__ void operator()(const f32x4 (&acc)[2][2][4][2], const Unit& u, int wr, int wc, int fr, int fq) const {
        const int row0 = u.pm * BM + wr * 64 + fr, c0 = u.pn * HALF + wc * 32 + 8 * fq;
#pragma unroll
        for (int ai = 0; ai < 2; ++ai)
#pragma unroll
            for (int m = 0; m < 4; ++m) { float o[8];
#pragma unroll
                for (int n = 0; n < 2; ++n)
#pragma unroll
                    for (int e = 0; e < 4; ++e) { const float gt = acc[ai][0][m][n][e], up = acc[ai][1][m][n][e];
                        o[4 * n + e] = gt * __builtin_amdgcn_rcpf(1.0f + __builtin_amdgcn_exp2f(-1.4426950408889634f * gt)) * up; }
                u32x4 w; w.x = cvt_pk_bf16(o[0], o[1]); w.y = cvt_pk_bf16(o[2], o[3]); w.z = cvt_pk_bf16(o[4], o[5]); w.w = cvt_pk_bf16(o[6], o[7]);
                *(u32x4*)(act + (size_t)(row0 + ai * HALF + m * 16) * 2816 + c0) = w; }
    }
};
template <class Epi, class Sched>
__device__ __forceinline__ void gemm_simple(const Gemm g, const Sched& S, const Epi& E) {
    const int tid = threadIdx.x, wid = __builtin_amdgcn_readfirstlane(tid >> 6), lane = tid & 63, wr = wid >> 2, wc = wid & 3, fr = lane & 15, fq = lane >> 4;
    const int K = g.K; Unit u;
    for (int i = 0; S.next(i, u); ++i) {
        f32x4 acc[2][2][4][2];
#pragma unroll
        for (int a = 0; a < 2; ++a)
#pragma unroll
            for (int b = 0; b < 2; ++b)
#pragma unroll
                for (int m = 0; m < 4; ++m)
#pragma unroll
                    for (int n = 0; n < 2; ++n) acc[a][b][m][n] = (f32x4){0.f, 0.f, 0.f, 0.f};
        const bf16_t* Ab = g.A + (size_t)(u.pm * BM + wr * 64 + fr) * K + fq * 8;
        const bf16_t* Bb = g.Bt + (size_t)(u.pn * BM + wc * 32 + fr) * K + fq * 8;
        for (int k0 = 0; k0 < K; k0 += 32) {
            bf16x8 a[2][4], b[2][2];
#pragma unroll
            for (int ai = 0; ai < 2; ++ai)
#pragma unroll
                for (int m = 0; m < 4; ++m) a[ai][m] = *(const bf16x8*)(Ab + (size_t)(ai * HALF + m * 16) * K + k0);
#pragma unroll
            for (int bj = 0; bj < 2; ++bj)
#pragma unroll
                for (int n = 0; n < 2; ++n) b[bj][n] = *(const bf16x8*)(Bb + (size_t)(bj * HALF + n * 16) * K + k0);
#pragma unroll
            for (int ai = 0; ai < 2; ++ai)
#pragma unroll
                for (int bj = 0; bj < 2; ++bj)
#pragma unroll
                    for (int m = 0; m < 4; ++m)
#pragma unroll
                        for (int n = 0; n < 2; ++n) acc[ai][bj][m][n] = __builtin_amdgcn_mfma_f32_16x16x32_bf16(b[bj][n], a[ai][m], acc[ai][bj][m][n], 0, 0, 0);
        }
        E(acc, u, wr, wc, fr, fq);
    }
}
}
#ifndef PG8_SP2
#define PG8_SP2 true
#endif
#ifndef PG8_ALIGN
#define PG8_ALIGN true
#endif
#include <hip/hip_bf16.h>
#include <cmath>
namespace attn_body {
using bf16=__hip_bfloat16;
using bf16x8=__attribute__((ext_vector_type(8)))short;
using s16x4=__attribute__((ext_vector_type(4)))short;
using f32x16=__attribute__((ext_vector_type(16)))float;
using u32x4=__attribute__((ext_vector_type(4)))unsigned;
constexpr int BATCH=8,NHEAD=8,NKV=2,SEQ=4096,D=64,QP=512,KP=128,OP=1024;
constexpr int NW=8,QBLK=32,QB=QBLK*NW,KVBLK=64,NQB=SEQ/QB;
constexpr int ATTN_UNIT_ROWS=QB;
__device__ __forceinline__ int crow(int r,int hi){return (r&3)+8*(r>>2)+4*hi;}
#define SBAR() __builtin_amdgcn_sched_barrier(0)
__device__ __forceinline__ void cmask(f32x16&p0,f32x16&p1,int jb,int qrel,int hi){
  const float NEG=-INFINITY; int kb=64*jb+4*hi;
  #pragma unroll
  for(int r=0;r<16;++r){int kv=kb+(r&3)+8*(r>>2); if(kv>qrel)p0[r]=NEG; if(kv+32>qrel)p1[r]=NEG;}
}

constexpr int NSLOT=3, SLOTB=8192;
constexpr int LDS_K=0, LDS_V=NSLOT*SLOTB, LDS_WS=2*NSLOT*SLOTB, LDS_OST=LDS_WS+NW*64*4, LDS_BYTES=LDS_OST+NW*4096;
constexpr float C2=0.125f*1.4426950408889634f;
__device__ __forceinline__ void glds16(const void*gsrc,unsigned lds_dst){unsigned keep;
  asm volatile("s_mov_b32 %0, m0\n\ts_mov_b32 m0, %2\n\ts_nop 0\n\tglobal_load_lds_dwordx4 %1, off\n\ts_mov_b32 m0, %0":"=&s"(keep):"v"(gsrc),"s"(lds_dst):"memory");}
__device__ __forceinline__ float max3f(float a,float b,float c){float r;asm("v_max3_f32 %0, %1, %2, %3":"=v"(r):"v"(a),"v"(b),"v"(c));return r;}
__device__ __forceinline__ float max2f(float a,float b){float r;asm("v_max_f32_e32 %0, %1, %2":"=v"(r):"v"(a),"v"(b));return r;}
__device__ __forceinline__ float fadd_s(float a,float b){float r;asm("v_add_f32_e32 %0, %1, %2":"=v"(r):"v"(a),"v"(b));return r;}
__device__ __forceinline__ float fsub_s(float a,float b){float r;asm("v_sub_f32_e32 %0, %1, %2":"=v"(r):"v"(a),"v"(b));return r;}
typedef float f32x2_t __attribute__((ext_vector_type(2))); typedef __bf16 bf16x2_t __attribute__((ext_vector_type(2)));
__device__ __forceinline__ unsigned cvtpk_s(float lo,float hi){f32x2_t v={lo,hi};bf16x2_t b=__builtin_convertvector(v,bf16x2_t);return __builtin_bit_cast(unsigned,b);}
#define WAIT_BAR(N) asm volatile("s_waitcnt vmcnt(" #N ") lgkmcnt(0)\n\ts_barrier":::"memory")

__device__ __forceinline__ void qkt(f32x16&p0,f32x16&p1,const char*Kslot,const bf16x8*qr,const f32x16&negm,int r32,int hi){
  const char*kb=Kslot+hi*1024+r32*16;
  #pragma unroll
  for(int d0=0;d0<4;++d0){
    const bf16x8 b0=*reinterpret_cast<const bf16x8*>(kb+d0*2048);
    const bf16x8 b1=*reinterpret_cast<const bf16x8*>(kb+d0*2048+512);
    if(d0==0){p0=__builtin_amdgcn_mfma_f32_32x32x16_bf16(b0,qr[0],negm,0,0,0);p1=__builtin_amdgcn_mfma_f32_32x32x16_bf16(b1,qr[0],negm,0,0,0);}
    else{p0=__builtin_amdgcn_mfma_f32_32x32x16_bf16(b0,qr[d0],p0,0,0,0);p1=__builtin_amdgcn_mfma_f32_32x32x16_bf16(b1,qr[d0],p1,0,0,0);}}
}
typedef __attribute__((address_space(3))) const char* lds_cptr;
typedef short v4i16_t __attribute__((ext_vector_type(4)));
__device__ __forceinline__ void kload8(bf16x8*kf,lds_cptr kp){
  kf[0]=*(const __attribute__((address_space(3))) bf16x8*)(kp);      kf[1]=*(const __attribute__((address_space(3))) bf16x8*)(kp+512);
  kf[2]=*(const __attribute__((address_space(3))) bf16x8*)(kp+2048); kf[3]=*(const __attribute__((address_space(3))) bf16x8*)(kp+2560);
  kf[4]=*(const __attribute__((address_space(3))) bf16x8*)(kp+4096); kf[5]=*(const __attribute__((address_space(3))) bf16x8*)(kp+4608);
  kf[6]=*(const __attribute__((address_space(3))) bf16x8*)(kp+6144); kf[7]=*(const __attribute__((address_space(3))) bf16x8*)(kp+6656);
}
__device__ __forceinline__ void kload2(bf16x8*kf,lds_cptr kp,int j){ kf[2*j]=*(const __attribute__((address_space(3))) bf16x8*)(kp+j*2048); kf[2*j+1]=*(const __attribute__((address_space(3))) bf16x8*)(kp+j*2048+512); }
__device__ __forceinline__ s16x4 vtr(lds_cptr p){ return __builtin_bit_cast(s16x4,__builtin_amdgcn_ds_read_tr16_b64_v4i16((__attribute__((address_space(3))) v4i16_t*)p)); }
__device__ __forceinline__ float rowmax(const f32x16&p0,const f32x16&p1){
  float a=max3f(p0[0],p0[1],p1[0]),b=max3f(p0[2],p0[3],p1[1]);a=max3f(a,p1[2],p1[3]);
  #pragma unroll
  for(int r=4;r<16;r+=4){a=max3f(a,p0[r],p0[r+1]);b=max3f(b,p0[r+2],p0[r+3]);a=max3f(a,p1[r],p1[r+1]);b=max3f(b,p1[r+2],p1[r+3]);}
  const float m=max2f(a,b);
  auto rr=__builtin_amdgcn_permlane32_swap(__float_as_uint(m),__float_as_uint(m),false,false);
  return max2f(__uint_as_float(rr[0]),__uint_as_float(rr[1]));
}
__device__ __forceinline__ void pv(f32x16*o,int vb,bf16x8 pa0,bf16x8 pa1,bf16x8 pa2,bf16x8 pa3){
  #pragma unroll
  for(int d0=0;d0<2;++d0){s16x4 lo[4],hi[4];
    #pragma unroll
    for(int ks=0;ks<4;++ks){
      asm volatile("ds_read_b64_tr_b16 %0,%1 offset:%c2":"=&v"(lo[ks]):"v"(vb),"i"(d0*4096+ks*1024):"memory");
      asm volatile("ds_read_b64_tr_b16 %0,%1 offset:%c2":"=&v"(hi[ks]):"v"(vb),"i"(d0*4096+ks*1024+512):"memory");}
    asm volatile("s_waitcnt lgkmcnt(0)":::"memory");SBAR();
    #define PK(k) (bf16x8){lo[k][0],lo[k][1],lo[k][2],lo[k][3],hi[k][0],hi[k][1],hi[k][2],hi[k][3]}
    o[d0]=__builtin_amdgcn_mfma_f32_32x32x16_bf16(pa0,PK(0),o[d0],0,0,0);
    o[d0]=__builtin_amdgcn_mfma_f32_32x32x16_bf16(pa1,PK(1),o[d0],0,0,0);
    o[d0]=__builtin_amdgcn_mfma_f32_32x32x16_bf16(pa2,PK(2),o[d0],0,0,0);
    o[d0]=__builtin_amdgcn_mfma_f32_32x32x16_bf16(pa3,PK(3),o[d0],0,0,0);
    #undef PK
  }
}

#ifndef ATTN_STORE16
#define ATTN_STORE16(p,v) (*(u32x4*)(p)=(v))
#endif
template<int THRL> __device__ __forceinline__ void attn_unit(int b,int h,int qb,const bf16*Q,const bf16*__restrict__ K,const bf16*__restrict__ V,bf16*O,char*shm){
  const int tid=threadIdx.x,lane=tid&63,r32=lane&31,hi=lane>>5; const int wid=__builtin_amdgcn_readfirstlane(tid>>6);
  const long rowbase=(long)b*SEQ; const int q0=qb*QB;
  const bf16*Qw=Q+(rowbase+q0+wid*QBLK)*QP+h*D;
  const int kvh=h/(NHEAD/NKV); const bf16*Kh=K+rowbase*KP+kvh*D,*Vh=V+rowbase*KP+kvh*D;
  const unsigned lds0=(unsigned)(uintptr_t)shm;
  float*wsf=(float*)(shm+LDS_WS)+wid*64;
  const bf16*ksrc=Kh+(long)lane*KP+wid*8;
  const bf16*vsrc=Vh+(long)(16*(wid&3)+(lane>>2))*KP+(wid>>2)*32+(lane&3)*8;
  const unsigned kdst=lds0+LDS_K+wid*1024, vdst=lds0+LDS_V+wid*1024;
  #define DMA_K(t,slot) glds16(ksrc+(long)(t)*KVBLK*KP,(unsigned)__builtin_amdgcn_readfirstlane(kdst+(slot)))
  #define DMA_V(t,slot) glds16(vsrc+(long)(t)*KVBLK*KP,(unsigned)__builtin_amdgcn_readfirstlane(vdst+(slot)))
  const int vb0=(int)(lds0+LDS_V)+((lane>>4)&1)*32+(lane&3)*8+(4*hi+((lane&15)>>2))*64;
  const char*Kbase=shm+LDS_K; bf16x8 kf[8];
  const lds_cptr shm3=(lds_cptr)shm; const lds_cptr kp0=shm3+LDS_K+hi*1024+r32*16; const lds_cptr vp0=shm3+LDS_V+((lane>>4)&1)*32+(lane&3)*8+(4*hi+((lane&15)>>2))*64;
  const int NT=SEQ/KVBLK;
  DMA_K(0,0);DMA_V(0,0);DMA_K(1,SLOTB);
  bf16x8 qr[4];
  #pragma unroll
  for(int d0=0;d0<4;++d0)qr[d0]=*reinterpret_cast<const bf16x8*>(&Qw[(long)r32*QP+d0*16+hi*8]);
  float mhat=0.f,l_reg=0.f;f32x16 o[2];o[0]=f32x16{};o[1]=f32x16{};f32x16 negm=f32x16{};asm volatile("":"+v"(negm));
  const int qrel=wid*QBLK+r32;
  #define CMASK(P0,P1,t) do{}while(0)
  bool resc=false;
  #define START(P0,P1) do{ const float rm=rowmax(P0,P1); resc=false; \
    { const float dl=rm; mhat=fadd_s(mhat,dl); \
      _Pragma("unroll") for(int r=0;r<16;++r){P0[r]=fsub_s(P0[r],dl);P1[r]=fsub_s(P1[r],dl);} \
      _Pragma("unroll") for(int r=0;r<16;++r)negm[r]=-mhat; asm volatile("":"+v"(negm)); } \
    _Pragma("unroll") for(int r=0;r<16;++r)P0[r]=__builtin_amdgcn_exp2f(P0[r]); }while(0)
  #define RESC() do{ if(resc){ asm volatile("s_waitcnt lgkmcnt(0)":::"memory"); \
      _Pragma("unroll") for(int d_=0;d_<2;++d_) _Pragma("unroll") for(int r=0;r<16;++r)o[d_][r]*=wsf[crow(r,hi)]; } }while(0)
  f32x16 pA0,pA1,pB0,pB1;
  int sl_prev=0,sl_cur=0,sl_next=SLOTB;
  #define ROT() do{sl_prev=sl_cur;sl_cur=sl_next;sl_next=(sl_next==(NSLOT-1)*SLOTB)?0:sl_next+SLOTB;}while(0)
  DMA_K(2,2*SLOTB);
  WAIT_BAR(3);
  qkt(pA0,pA1,Kbase,qr,negm,r32,hi);asm volatile("s_nop 15\n\ts_nop 7":"+v"(pA0),"+v"(pA1));CMASK(pA0,pA1,0);
  START(pA0,pA1);
  _Pragma("unroll") for(int r=0;r<16;++r)pA1[r]=__builtin_amdgcn_exp2f(pA1[r]);
  WAIT_BAR(0);
  DMA_K(3,0);DMA_V(1,SLOTB);
  ROT();
  kload8(kf,kp0+sl_cur);
  WAIT_BAR(2);
  s16x4 vlo[8],vhi[8]; u32x4 pw0,pw1,pw2,pw3;
  #define PKW(P,B) cvtpk_s(P[B],P[B+1])
  #define PAF(k) __builtin_bit_cast(bf16x8,pw##k)
  #define VFR(i) (bf16x8){vlo[i][0],vlo[i][1],vlo[i][2],vlo[i][3],vhi[i][0],vhi[i][1],vhi[i][2],vhi[i][3]}
  #define PIN(x) asm volatile("":"+v"(x))
  #define MX3(a,b,c) __builtin_fmaxf(__builtin_fmaxf((a),(b)),(c))
  #define GAPA(MF,A0,A1,A2,A3,W0,W1,PW) do{ MF; sacc+=A0; sacc+=A1; sacc+=A2; sacc+=A3; PIN(sacc); W0; W1; PIN(PW); SBAR(); }while(0)
  #define EX(v) __builtin_amdgcn_exp2f(v)
  #define GAPB(MF,X,B) do{ MF; X[B]=EX(X[B]); X[B+1]=EX(X[B+1]); X[B+2]=EX(X[B+2]); X[B+3]=EX(X[B+3]); PIN(X); SBAR(); }while(0)
  #define VRD(i) do{ vlo[i]=vtr(vp_+(((i)>>2)*4096+((i)&3)*1024)); vhi[i]=vtr(vp_+(((i)>>2)*4096+((i)&3)*1024+512)); }while(0)
  #define KRD(G,j) do{ if(G){ kload2(kf,kp0+sl_next,j); SBAR(); } }while(0)
  #define STEP(C0,C1,P0,P1,t,GK,GV,GL) do{ SBAR(); \
    const lds_cptr vp_=vp0+sl_prev; \
    VRD(0); SBAR(); float sacc=(P0[0]+P0[1]); \
    GAPA(C0=__builtin_amdgcn_mfma_f32_32x32x16_bf16(kf[0],qr[0],negm,0,0,0), P0[2],P0[3],P0[4],P0[5],     pw0[0]=PKW(P0,0), pw0[1]=PKW(P0,2), pw0); \
    VRD(4); SBAR(); GAPA(C1=__builtin_amdgcn_mfma_f32_32x32x16_bf16(kf[1],qr[0],negm,0,0,0), P0[6],P0[7],P0[8],P0[9],     pw0[2]=PKW(P0,4), pw0[3]=PKW(P0,6), pw0); \
    VRD(1); SBAR(); GAPA(C0=__builtin_amdgcn_mfma_f32_32x32x16_bf16(kf[2],qr[1],C0,0,0,0),   P0[10],P0[11],P0[12],P0[13], pw1[0]=PKW(P0,8), pw1[1]=PKW(P0,10), pw1); \
    VRD(5); SBAR(); GAPA(C1=__builtin_amdgcn_mfma_f32_32x32x16_bf16(kf[3],qr[1],C1,0,0,0),   P0[14],P0[15],P1[0],P1[1],   pw1[2]=PKW(P0,12),pw1[3]=PKW(P0,14), pw1); \
    VRD(2); SBAR(); GAPA(C0=__builtin_amdgcn_mfma_f32_32x32x16_bf16(kf[4],qr[2],C0,0,0,0),   P1[2],P1[3],P1[4],P1[5],     pw2[0]=PKW(P1,0), pw2[1]=PKW(P1,2), pw2); \
    VRD(6); SBAR(); GAPA(C1=__builtin_amdgcn_mfma_f32_32x32x16_bf16(kf[5],qr[2],C1,0,0,0),   P1[6],P1[7],P1[8],P1[9],     pw2[2]=PKW(P1,4), pw2[3]=PKW(P1,6), pw2); \
    VRD(3); SBAR(); GAPA(C0=__builtin_amdgcn_mfma_f32_32x32x16_bf16(kf[6],qr[3],C0,0,0,0),   P1[10],P1[11],P1[12],P1[13], pw3[0]=PKW(P1,8), pw3[1]=PKW(P1,10), pw3); \
    VRD(7); SBAR(); GAPA(C1=__builtin_amdgcn_mfma_f32_32x32x16_bf16(kf[7],qr[3],C1,0,0,0),   P1[14],P1[15],0.f,0.f,       pw3[2]=PKW(P1,12),pw3[3]=PKW(P1,14), pw3); \
    l_reg+=sacc; \
    if(GK){DMA_K((t)+3,sl_cur);} if(GV){DMA_V((t)+1,sl_next);} \
    CMASK(C0,C1,t); \
    { float a=MX3(C0[0],C0[1],C1[0]),b=MX3(C0[2],C0[3],C1[1]); a=MX3(a,C1[2],C1[3]); \
      _Pragma("unroll") for(int r=4;r<16;r+=4){a=MX3(a,C0[r],C0[r+1]);b=MX3(b,C0[r+2],C0[r+3]);a=MX3(a,C1[r],C1[r+1]);b=MX3(b,C1[r+2],C1[r+3]);} \
      float rm=__builtin_fmaxf(a,b); { auto rr=__builtin_amdgcn_permlane32_swap(__float_as_uint(rm),__float_as_uint(rm),false,false); rm=__builtin_fmaxf(__uint_as_float(rr[0]),__uint_as_float(rr[1])); } \
      resc=false; \
      if(__builtin_expect(__any(rm>(float)THRL),0)){ const float dl=__builtin_fmaxf(rm,0.f); mhat+=dl; \
        _Pragma("unroll") for(int r=0;r<16;++r){C0[r]-=dl;C1[r]-=dl;} \
        _Pragma("unroll") for(int r=0;r<16;++r)negm[r]=-mhat; asm volatile("":"+v"(negm)); \
        const float f=__builtin_amdgcn_exp2f(-dl); l_reg*=f; if(hi==0)wsf[r32]=f; resc=true; } } \
    SBAR(); \
    GAPB(o[0]=__builtin_amdgcn_mfma_f32_32x32x16_bf16(PAF(0),VFR(0),o[0],0,0,0), C0,0); \
    GAPB(o[1]=__builtin_amdgcn_mfma_f32_32x32x16_bf16(PAF(0),VFR(4),o[1],0,0,0), C0,4); \
    KRD(GL,0); GAPB(o[0]=__builtin_amdgcn_mfma_f32_32x32x16_bf16(PAF(1),VFR(1),o[0],0,0,0), C0,8); \
    KRD(GL,1); GAPB(o[1]=__builtin_amdgcn_mfma_f32_32x32x16_bf16(PAF(1),VFR(5),o[1],0,0,0), C0,12); \
    KRD(GL,2); GAPB(o[0]=__builtin_amdgcn_mfma_f32_32x32x16_bf16(PAF(2),VFR(2),o[0],0,0,0), C1,0); \
    KRD(GL,3); GAPB(o[1]=__builtin_amdgcn_mfma_f32_32x32x16_bf16(PAF(2),VFR(6),o[1],0,0,0), C1,4); \
    GAPB(o[0]=__builtin_amdgcn_mfma_f32_32x32x16_bf16(PAF(3),VFR(3),o[0],0,0,0), C1,8); \
    GAPB(o[1]=__builtin_amdgcn_mfma_f32_32x32x16_bf16(PAF(3),VFR(7),o[1],0,0,0), C1,12); \
    }while(0)
  int t=1;
  #undef CMASK
  #define CMASK(P0,P1,t) do{}while(0)
  for(;t+5<NT;t+=2){
    STEP(pB0,pB1,pA0,pA1,t,true,true,true);     WAIT_BAR(2); RESC(); ROT();
    STEP(pA0,pA1,pB0,pB1,t+1,true,true,true);   WAIT_BAR(2); RESC(); ROT();
  }
  #undef CMASK
  #define CMASK(P0,P1,t) do{}while(0)
  #define ENDW(tt) do{ if((tt)+3<NT){WAIT_BAR(2);} else if((tt)+2<NT){WAIT_BAR(1);} else {WAIT_BAR(0);} }while(0)
  for(;t+1<NT;t+=2){
    STEP(pB0,pB1,pA0,pA1,t,(t+3<NT),(t+1<NT),(t+1<NT));       ENDW(t);   RESC(); ROT();
    STEP(pA0,pA1,pB0,pB1,t+1,(t+4<NT),(t+2<NT),(t+2<NT));     ENDW(t+1); RESC(); ROT();
  }
  STEP(pB0,pB1,pA0,pA1,NT-1,false,false,false); RESC();
  { float sacc=pB0[0]+pB0[1]; _Pragma("unroll") for(int r=2;r<16;++r)sacc+=pB0[r]; _Pragma("unroll") for(int r=0;r<16;++r)sacc+=pB1[r]; l_reg+=sacc;
    pw0=(u32x4){PKW(pB0,0),PKW(pB0,2),PKW(pB0,4),PKW(pB0,6)};pw1=(u32x4){PKW(pB0,8),PKW(pB0,10),PKW(pB0,12),PKW(pB0,14)};pw2=(u32x4){PKW(pB1,0),PKW(pB1,2),PKW(pB1,4),PKW(pB1,6)};pw3=(u32x4){PKW(pB1,8),PKW(pB1,10),PKW(pB1,12),PKW(pB1,14)};
    SBAR(); pv(o,vb0+sl_cur,PAF(0),PAF(1),PAF(2),PAF(3)); }
  #undef PKW
  #undef PAF
  #undef VFR
  #undef PIN
  #undef MX3
  #undef GAPA
  #undef GAPB
  #undef EX
  #undef VRD
  #undef KRD
  #undef STEP
  #undef ENDW
  {auto rr=__builtin_amdgcn_permlane32_swap(__float_as_uint(l_reg),__float_as_uint(l_reg),false,false);l_reg=__uint_as_float(rr[0])+__uint_as_float(rr[1]);}
  if(hi==0)wsf[32+r32]=l_reg;asm volatile("s_waitcnt lgkmcnt(0)":::"memory");
  float rli[16];
  #pragma unroll
  for(int r=0;r<16;++r)rli[r]=__builtin_amdgcn_rcpf(wsf[32+crow(r,hi)]);
  bf16*Ow=O+(rowbase+q0+wid*QBLK)*OP+h*D;
  { bf16*stg=(bf16*)(shm+LDS_OST)+wid*2048;
    #pragma unroll
    for(int r=0;r<16;++r){const int orow=crow(r,hi);
      #pragma unroll
      for(int d0=0;d0<2;++d0)stg[orow*64+d0*32+r32]=__float2bfloat16(o[d0][r]*rli[r]);}
    asm volatile("s_waitcnt lgkmcnt(0)":::"memory");
    #pragma unroll
    for(int i=0;i<4;++i){const int row=i*8+(lane>>3),ch=lane&7; const u32x4 v=*(const u32x4*)(stg+row*64+ch*8); ATTN_STORE16(Ow+(long)row*OP+ch*8,v);} }
  asm volatile("s_waitcnt lgkmcnt(0)\n\ts_barrier":::"memory");
  #undef DMA_K
  #undef DMA_V
  #undef CMASK
  #undef START
  #undef RESC
  #undef ROT
}
constexpr int ATTN_LDS_BYTES=LDS_BYTES;
struct AttnTensors { const bf16* Q; const bf16* K; const bf16* V; bf16* O; };
struct AttnUnit { int bh; int qb; };
struct StaticOrder {
  int vcu, G;
  __device__ __forceinline__ explicit StaticOrder(int grid,int block):vcu((grid%8==0)?(block%8)*(grid/8)+block/8:block),G(grid){}
  __device__ __forceinline__ bool next(int i,AttnUnit&u)const{ const int per=(BATCH*NHEAD*NQB+G-1)/G; if(i>=per)return false; const int U=vcu*per+i; if(U>=BATCH*NHEAD*NQB)return false; u.bh=U/NQB; u.qb=U%NQB; return true; }
};
struct QueueOrder {
  unsigned* ctr; volatile __attribute__((address_space(3))) unsigned* slot;
  __device__ __forceinline__ bool next(int,AttnUnit&u)const{
    if(threadIdx.x==0)*slot=__hip_atomic_fetch_add(ctr,1u,__ATOMIC_RELAXED,__HIP_MEMORY_SCOPE_AGENT);
    __syncthreads(); const unsigned U=*slot; if(U>=(unsigned)(BATCH*NHEAD*NQB))return false; u.bh=(int)(U/NQB); u.qb=(int)(U%NQB); return true; }
};
template<class Sched,int THRL=8> __device__ __forceinline__ void attn_phase(char*lds,const AttnTensors&T,const Sched&S){
  AttnUnit u;
  for(int i=0;S.next(i,u);++i){ attn_unit<THRL>(u.bh/NHEAD,u.bh%NHEAD,u.qb,T.Q,T.K,T.V,T.O,lds); }
}
#undef SBAR
#undef WAIT_BAR
}
#define GAS __attribute__((address_space(1)))
#define LAS __attribute__((address_space(3)))
typedef unsigned short bf16;
typedef unsigned v4u __attribute__((ext_vector_type(4)));
typedef float f32x4 __attribute__((ext_vector_type(4)));
typedef short bf16x8 __attribute__((ext_vector_type(8)));
typedef GAS unsigned gu32;
typedef GAS unsigned long long gu64;
#define RLX_AGENT __ATOMIC_RELAXED, __HIP_MEMORY_SCOPE_AGENT
#define LDS_WAIT() asm volatile("s_waitcnt lgkmcnt(0)" ::: "memory")
#define VM_WAIT() asm volatile("s_waitcnt vmcnt(0)" ::: "memory")
__device__ __forceinline__ unsigned long long rt() { return __builtin_amdgcn_s_memrealtime(); }
__device__ __forceinline__ unsigned f2bf(float f) { unsigned u = __builtin_bit_cast(unsigned, f); return (u + 0x7fffu + ((u >> 16) & 1u)) >> 16; }
__device__ __forceinline__ unsigned pk2(float lo, float hi) { return f2bf(lo) | (f2bf(hi) << 16); }

#define XB_TMO      128
#define XB_XCNT(j)  (256  + 64 * (j))
#define XB_XSUB(j)  (1280 + 64 * (j))
#define XB_XGEN(j)  (2304 + 64 * (j))
#define XB_TOP      3328
#define XB_TOPGEN   3392
#define XCD_BAR_WORDS 3456
#ifndef XB_SPIN_CAP
#define XB_SPIN_CAP (1u << 26)
#endif

__device__ __forceinline__ unsigned xb_ld(unsigned* p)              { return __hip_atomic_load(p, __ATOMIC_RELAXED, __HIP_MEMORY_SCOPE_AGENT); }
__device__ __forceinline__ unsigned xb_add(unsigned* p, unsigned v) { return __hip_atomic_fetch_add(p, v, __ATOMIC_RELAXED, __HIP_MEMORY_SCOPE_AGENT); }
__device__ __forceinline__ unsigned xb_xcc_id() { return (unsigned)__builtin_amdgcn_s_getreg((3 << 11) | 20) & 0xFu; }
#define XB_SPIN(cond, bar) do { unsigned _sp = 0; while (cond) { __builtin_amdgcn_s_sleep(1); \
    if ((++_sp & 255u) == 0u) { if (xb_ld(&(bar)[XB_TMO])) break; if (_sp > XB_SPIN_CAP) { atomicAdd(&(bar)[XB_TMO], 1u); break; } } } } while (0)

struct XcdBarrier {
    unsigned* bar; unsigned x;
    volatile LAS unsigned* st;
};

__device__ __forceinline__ XcdBarrier xcd_barrier_post(unsigned* bar, volatile LAS unsigned* st) {
    XcdBarrier b; b.bar = bar; b.x = xb_xcc_id(); b.st = st;
    if (threadIdx.x == 0) (void)xb_add(&bar[XB_XCNT(b.x)], 1u);
    return b;
}
__device__ __forceinline__ void xcd_barrier_complete(unsigned* bar, unsigned x, unsigned& nloc, unsigned& nx) {
    const unsigned G = gridDim.x * gridDim.y * gridDim.z;
    unsigned sum, cnt, mine, sp = 0u;
    for (;;) {
        sum = 0u; cnt = 0u; mine = 0u;
#pragma unroll
        for (unsigned j = 0; j < 16; ++j) { const unsigned c = xb_ld(&bar[XB_XCNT(j)]); sum += c; cnt += (c > 0u) ? 1u : 0u; mine = (j == x) ? c : mine; }
        if (sum == G) break;
        __builtin_amdgcn_s_sleep(1);
        if ((++sp & 255u) == 0u) { if (xb_ld(&bar[XB_TMO])) break; if (sp > XB_SPIN_CAP) { atomicAdd(&bar[XB_TMO], 1u); break; } }
    }
    nloc = mine > 0u ? mine : 1u; nx = cnt > 0u ? cnt : 1u;
}

__device__ __forceinline__ void xcd_barrier(const XcdBarrier& b) {
    asm volatile("s_waitcnt vmcnt(0)" ::: "memory");
    __syncthreads();
    if (threadIdx.x == 0) {
        unsigned* bar = b.bar;
        __builtin_amdgcn_s_waitcnt(0);
        unsigned nloc = b.st[0], nx = b.st[1];
        if (nloc == 0u) { xcd_barrier_complete(bar, b.x, nloc, nx); b.st[0] = nloc; b.st[1] = nx; }
        const unsigned old = xb_add(&bar[XB_XSUB(b.x)], 1u);
        const unsigned gen = old / nloc;
        if (old + 1u == (gen + 1u) * nloc) {
            __builtin_amdgcn_fence(__ATOMIC_RELEASE, "agent");
            asm volatile("s_waitcnt vmcnt(0)" ::: "memory");
            const unsigned og = xb_add(&bar[XB_TOP], 1u);
            const unsigned tg = og / nx;
            if (og + 1u == (tg + 1u) * nx) xb_add(&bar[XB_TOPGEN], 1u);
            else XB_SPIN(xb_ld(&bar[XB_TOPGEN]) == tg, bar);
            __builtin_amdgcn_fence(__ATOMIC_ACQUIRE, "agent");
            xb_add(&bar[XB_XGEN(b.x)], 1u);
            asm volatile("s_waitcnt vmcnt(0)" ::: "memory");
        } else {
            XB_SPIN(xb_ld(&bar[XB_XGEN(b.x)]) == gen, bar);
            __builtin_amdgcn_fence(__ATOMIC_ACQUIRE, "agent");
            asm volatile("s_waitcnt vmcnt(0)" ::: "memory");
        }
    }
    __syncthreads();
}
struct Args { const float* in[18]; float* out; unsigned char* ws; int ph_lo, ph_hi; };
enum { I_X = 0, I_C, I_WADA, I_BADA, I_NMG, I_WIN, I_QG, I_KG, I_CONVW, I_CONVB, I_GATEB, I_MNG, I_WOUT, I_NFG, I_WGATE, I_WUP, I_WDOWN, I_FNG };

__device__ __forceinline__ float wave_sum(float v) {
#pragma unroll
    for (int o = 1; o < 64; o <<= 1) v += __shfl_xor(v, o);
    return v;
}
__device__ __forceinline__ float bf2f(bf16 h) { return __builtin_bit_cast(float, (unsigned)h << 16); }
__device__ __forceinline__ float bflo(unsigned w) { return __builtin_bit_cast(float, w << 16); }
__device__ __forceinline__ float bfhi(unsigned w) { return __builtin_bit_cast(float, w & 0xffff0000u); }

__device__ __forceinline__ int colmap_in(int j) {
    const int pn = j >> 8, jj = j & 255, bj = jj >> 7, wc = (jj >> 5) & 3, n = (jj >> 4) & 1, fq = (jj >> 2) & 3, e = jj & 3;
    return (pn <= 2) ? 256 * pn + 64 * wc + 16 * (2 * bj + n) + 4 * fq + e : 256 * pn + 128 * bj + 32 * wc + 8 * fq + 4 * n + e;
}
__device__ __forceinline__ int colmap_gu(int j) {
    const int pn = j >> 8, jj = j & 255, wc = (jj >> 5) & 3, n = (jj >> 4) & 1, fq = (jj >> 2) & 3, e = jj & 3;
    return 128 * pn + 32 * wc + 8 * fq + 4 * n + e;
}
__device__ __forceinline__ void transpose_item(const float* W, int ldw, int K, bf16* WT, int n0, int k0, int srccol, LAS float* scr, int lane) {
#pragma unroll 8
    for (int i = 0; i < 32; ++i) { const int kk = 2 * i + (lane >> 5); scr[kk * 33 + (lane & 31)] = W[(size_t)(k0 + kk) * ldw + srccol]; }
    LDS_WAIT(); asm volatile("" ::: "memory");
    const int c = lane & 7;
#pragma unroll
    for (int j = 0; j < 4; ++j) { const int n = (lane >> 3) + 8 * j; const LAS float* s = scr + (8 * c) * 33 + n;
        v4u o; o.x = pk2(s[0 * 33], s[1 * 33]); o.y = pk2(s[2 * 33], s[3 * 33]); o.z = pk2(s[4 * 33], s[5 * 33]); o.w = pk2(s[6 * 33], s[7 * 33]);
        *(GAS v4u*)(WT + (size_t)(n0 + n) * K + k0 + 8 * c) = o; }
    LDS_WAIT(); asm volatile("" ::: "memory");
}

__device__ __forceinline__ void p0_prologue(const Args& A, LAS unsigned char* lds, int tid, int lane, int wave, int vcu, int G) {
    unsigned char* ws = A.ws;
    LAS float* sc = (LAS float*)(lds + 73728);
    for (int i = tid; i < 8192; i += NTHREADS) { const int b = i >> 10, k = i & 1023; const float cv = A.in[I_C][i]; sc[k * 8 + b] = cv / (1.0f + expf(-cv)); }
    __syncthreads();
    LAS float* scr = (LAS float*)(lds + wave * 9216);
    const int gw = vcu * NWAVES + wave, NGW = G * NWAVES;
    constexpr int I_MOD = 96 * 8, T_IN = 16 * 88, T_OUT = 16 * 32, T_GU = 16 * 176, T_DN = 44 * 32;
    constexpr int NITEMS = I_MOD + T_IN + T_OUT + T_GU + T_DN;
    float* mod = (float*)(ws + WS_MOD);
    for (int it = gw; it < NITEMS; it += NGW) {
        int r = it;
        if (r < I_MOD) {
            const int cg = r >> 3, ks = r & 7, col = cg * 64 + lane; const float* w = A.in[I_WADA] + (size_t)(ks * 128) * NMOD + col;
            float acc[8];
#pragma unroll
            for (int b = 0; b < 8; ++b) acc[b] = 0.f;
#pragma unroll 8
            for (int kk = 0; kk < 128; ++kk) { const float wv = w[(size_t)kk * NMOD]; const f32x4 s0 = *(const LAS f32x4*)(sc + (ks * 128 + kk) * 8), s1 = *(const LAS f32x4*)(sc + (ks * 128 + kk) * 8 + 4);
                acc[0] += s0[0] * wv; acc[1] += s0[1] * wv; acc[2] += s0[2] * wv; acc[3] += s0[3] * wv; acc[4] += s1[0] * wv; acc[5] += s1[1] * wv; acc[6] += s1[2] * wv; acc[7] += s1[3] * wv; }
            const float bias = (ks == 0) ? A.in[I_BADA][col] : 0.f;
#pragma unroll
            for (int b = 0; b < 8; ++b) atomicAdd(mod + b * NMOD + col, acc[b] + bias);
            continue;
        }
        r -= I_MOD;
        if (r < T_IN) { const int kb = r / 88, nb = r % 88; transpose_item(A.in[I_WIN], NIN, DMODEL, (bf16*)(ws + WS_WIN), 32 * nb, 64 * kb, colmap_in(32 * nb + (lane & 31)), scr, lane); continue; }
        r -= T_IN;
        if (r < T_OUT) { const int kb = r / 32, nb = r % 32; transpose_item(A.in[I_WOUT], DMODEL, DMODEL, (bf16*)(ws + WS_WO), 32 * nb, 64 * kb, 32 * nb + (lane & 31), scr, lane); continue; }
        r -= T_OUT;
        if (r < T_GU) { const int kb = r / 176, nb = r % 176; const int j0 = 32 * nb; const float* W = ((j0 >> 7) & 1) ? A.in[I_WUP] : A.in[I_WGATE];
            transpose_item(W, FFH, DMODEL, (bf16*)(ws + WS_WGU), j0, 64 * kb, colmap_gu(j0 + (lane & 31)), scr, lane); continue; }
        r -= T_GU;
        { const int kb = r / 32, nb = r % 32; transpose_item(A.in[I_WDOWN], DMODEL, FFH, (bf16*)(ws + WS_WD), 32 * nb, 64 * kb, 32 * nb + (lane & 31), scr, lane); }
    }
    if (blockIdx.x == 0) {
        for (int i = tid; i < 1024; i += NTHREADS) { const int pos = i >> 4, f = i & 15; const float inv = powf(10000.0f, -(float)(2 * f) / 32.0f); const float ang = (float)pos * inv;
            ((float*)(ws + WS_TABC))[i] = cosf(ang); ((float*)(ws + WS_TABS))[i] = sinf(ang); }
        if (tid < 128) ((float*)(ws + WS_QKG))[tid] = (tid < 64) ? A.in[I_QG][tid] : A.in[I_KG][tid - 64];
    }
    if (blockIdx.x == 1 % G) {
        for (int i = tid; i < 16 * 1024; i += NTHREADS) { const int gi = i >> 10, k = i & 1023; ((bf16*)(ws + WS_WGT))[i] = (bf16)f2bf(A.in[I_WIN][(size_t)k * NIN + NPROJ + gi]); }
    }
}

template <int MODE> __device__ __forceinline__ void row_pass(const Args& A, int lane, int gw, int NGW) {
    const float* src = (MODE == 0) ? A.in[I_X] : A.out; const float* g = (MODE == 0) ? A.in[I_NMG] : (MODE == 1) ? A.in[I_NFG] : A.in[I_FNG];
    const float* mod = (const float*)(A.ws + WS_MOD); bf16* XN = (bf16*)(A.ws + WS_XN);
    for (int rg = gw; rg < M / 16; rg += NGW) {
        const int b = (rg * 16) >> 12; f32x4 gp[4], sh[4];
#pragma unroll
        for (int j = 0; j < 4; ++j) { const int col = 4 * lane + 256 * j; gp[j] = *(const f32x4*)(g + col);
            if (MODE < 2) { const int o = (MODE == 0) ? 0 : 3072; const f32x4 s = *(const f32x4*)(mod + b * NMOD + o + 1024 + col); gp[j] = gp[j] * (s + 1.0f); sh[j] = *(const f32x4*)(mod + b * NMOD + o + col); } }
        for (int i = 0; i < 16; ++i) {
            const size_t row = (size_t)rg * 16 + i; const f32x4* xr = (const f32x4*)(src + row * DMODEL) + lane;
            f32x4 v[4]; float s = 0.f;
#pragma unroll
            for (int j = 0; j < 4; ++j) { v[j] = xr[64 * j]; s += (v[j][0] * v[j][0] + v[j][1] * v[j][1]) + (v[j][2] * v[j][2] + v[j][3] * v[j][3]); }
            const float rstd = 1.0f / sqrtf(wave_sum(s) * (1.0f / DMODEL) + EPS);
            if (MODE < 2) {
                unsigned long long* o8 = (unsigned long long*)(XN + row * DMODEL) + lane;
#pragma unroll
                for (int j = 0; j < 4; ++j) { const f32x4 y = v[j] * rstd * gp[j] + sh[j]; o8[64 * j] = (unsigned long long)pk2(y[0], y[1]) | ((unsigned long long)pk2(y[2], y[3]) << 32); }
            } else {
                f32x4* o = (f32x4*)(A.out + row * DMODEL) + lane;
#pragma unroll
                for (int j = 0; j < 4; ++j) o[64 * j] = v[j] * rstd * gp[j];
            }
        }
    }
}
__device__ __forceinline__ void gates_pass(const Args& A, int lane, int gw, int NGW) {
    const bf16* XN = (const bf16*)(A.ws + WS_XN); const bf16* WgT = (const bf16*)(A.ws + WS_WGT); float* GT = (float*)(A.ws + WS_GATES);
    const int fr = lane & 15, fq = lane >> 4; const f32x4 gb = *(const f32x4*)(A.in[I_GATEB] + 4 * fq);
    for (int rg = gw; rg < M / 16; rg += NGW) {
        f32x4 acc = {0.f, 0.f, 0.f, 0.f}; const bf16* ap = XN + ((size_t)rg * 16 + fr) * DMODEL + 8 * fq; const bf16* bp = WgT + (size_t)fr * DMODEL + 8 * fq;
#pragma unroll 4
        for (int k0 = 0; k0 < DMODEL; k0 += 32) acc = __builtin_amdgcn_mfma_f32_16x16x32_bf16(*(const bf16x8*)(bp + k0), *(const bf16x8*)(ap + k0), acc, 0, 0, 0);
        *(f32x4*)(GT + ((size_t)rg * 16 + fr) * 16 + 4 * fq) = acc + gb;
    }
}
namespace ml {
typedef float f32x16 __attribute__((ext_vector_type(16)));
typedef short s16x4 __attribute__((ext_vector_type(4)));
typedef short v4i16_t __attribute__((ext_vector_type(4)));
#define ML_MFMA(a, b, c) __builtin_amdgcn_mfma_f32_32x32x16_bf16((a), (b), (c), 0, 0, 0)
__device__ __forceinline__ int crow(int r, int hi) { return (r & 3) + 8 * (r >> 2) + 4 * hi; }
__device__ __forceinline__ unsigned off_b(unsigned row, unsigned ch) { return 256u * row + 16u * (ch ^ (((row & 3) << 2) | ((row >> 2) & 3))); }
__device__ __forceinline__ unsigned cvtpk(float lo, float hi) { typedef float f2 __attribute__((ext_vector_type(2))); typedef __bf16 b2 __attribute__((ext_vector_type(2))); f2 v = {lo, hi}; b2 r = __builtin_convertvector(v, b2); return __builtin_bit_cast(unsigned, r); }
__device__ __forceinline__ bf16x8 pack8(const f32x16& x, int s) { v4u p; p.x = cvtpk(x[8 * s], x[8 * s + 1]); p.y = cvtpk(x[8 * s + 2], x[8 * s + 3]); p.z = cvtpk(x[8 * s + 4], x[8 * s + 5]); p.w = cvtpk(x[8 * s + 6], x[8 * s + 7]); return __builtin_bit_cast(bf16x8, p); }
constexpr float KSCALE = 0.08838834764831845f;
__device__ __forceinline__ void prep_pass(const Args& A, LAS unsigned char* lds, int tid, int bx, int G) {
    const bf16* QKM = (const bf16*)(A.ws + WS_QKM); const bf16* VM = (const bf16*)(A.ws + WS_VM);
    bf16* QC = (bf16*)(A.ws + WS_QC); bf16* KC = (bf16*)(A.ws + WS_KC); bf16* VF = (bf16*)(A.ws + WS_VF);
    for (int it = bx; it < 512 + 2048; it += G) {
        if (it < 512) {
            const int b = it >> 6, c = it & 63, ch = 2 * tid; const float* cw = A.in[I_CONVW]; const float* cb = A.in[I_CONVB];
            float w0[5], w1[5];
#pragma unroll
            for (int j = 0; j < 5; ++j) { w0[j] = cw[j * 1024 + ch]; w1[j] = cw[j * 1024 + ch + 1]; }
            const float b0 = cb[ch], b1 = cb[ch + 1]; const float osc = (ch >= 512) ? KSCALE : 1.0f;
            unsigned xr[68];
#pragma unroll
            for (int i = 0; i < 68; ++i) { const int p = 64 * c - 2 + i; xr[i] = (p >= 0 && p < SEQ) ? *(const unsigned*)(QKM + ((size_t)b * SEQ + p) * 1024 + ch) : 0u; }
            bf16* dst = (ch < 512) ? QC + ch : KC + (ch - 512);
#pragma unroll
            for (int i = 0; i < 64; ++i) { float y0 = b0, y1 = b1;
#pragma unroll
                for (int j = 0; j < 5; ++j) { y0 += w0[j] * bflo(xr[i + j]); y1 += w1[j] * bfhi(xr[i + j]); }
                y0 = y0 / (1.0f + __expf(-y0)) * osc; y1 = y1 / (1.0f + __expf(-y1)) * osc;
                *(unsigned*)(dst + ((size_t)b * SEQ + 64 * c + i) * 512) = pk2(y0, y1); }
        } else {
            const int r = it - 512, b = r >> 8, c = (r >> 2) & 63, h = r & 3;
#pragma unroll
            for (int i = 0; i < 2; ++i) { const int idx = tid + NTHREADS * i, row = idx >> 4, ch = idx & 15; *(LAS v4u*)(lds + row * 256 + ch * 16) = *(const v4u*)(VM + ((size_t)b * SEQ + 64 * c + row) * 512 + h * 128 + ch * 8); }
            __syncthreads();
            bf16* blk = VF + (size_t)((b * 4 + h) * 64 + c) * 8192;
#pragma unroll
            for (int i = 0; i < 2; ++i) { const int o = tid + NTHREADS * i, ln = o & 63, ks = (o >> 6) & 3, vb = o >> 8, j = ln & 31, hi = ln >> 5; unsigned e[8];
#pragma unroll
                for (int jj = 0; jj < 8; ++jj) { const int s = 16 * ks + 8 * (jj >> 2) + 4 * hi + (jj & 3); e[jj] = *(const LAS unsigned short*)(lds + s * 256 + (32 * vb + j) * 2); }
                v4u w; w.x = e[0] | (e[1] << 16); w.y = e[2] | (e[3] << 16); w.z = e[4] | (e[5] << 16); w.w = e[6] | (e[7] << 16);
                *(v4u*)(blk + (size_t)o * 8) = w; }
            __syncthreads();
        }
    }
}

constexpr int ML_XCH = 131072, ML_VEC = 143360;
constexpr int V_SCAN = 0  , V_DENX = 640  , V_DQ = 736  , V_RD = 992  , V_NVS = 1248  , V_NP = 1376  , V_END = 1888;
static_assert(ML_VEC + 2 * 8192 <= LDSCTL_OFF && V_END * 4 <= 8192, "mLSTM LDS map");

__device__ __forceinline__ void mlstm_item(const Args& A, int item, LAS unsigned char* L, int tid) {
    const int b = item >> 2, h = item & 3;
    const int lane = tid & 63, wave = __builtin_amdgcn_readfirstlane(tid >> 6), half = wave >> 2, w = wave & 3, dir = half, r32 = lane & 31, hh = lane >> 5;
    const bf16* QC = (const bf16*)(A.ws + WS_QC); const bf16* KC = (const bf16*)(A.ws + WS_KC); const bf16* VF = (const bf16*)(A.ws + WS_VF); const float* GT = (const float*)(A.ws + WS_GATES);
    float* HF = (float*)(A.ws + WS_HF) + (size_t)dir * M * 512;
    LAS float* VEC = (LAS float*)(L + ML_VEC + half * 8192);
    LAS unsigned char* XCH = L + ML_XCH + half * 6144;
    const size_t rowbase = (size_t)b * SEQ;
    const int sbt = (w == 2) ? 1 : ((w == 1) ? dir : 0), tbt = (w == 2) ? 1 : ((w == 1) ? (1 - dir) : 0);
    f32x16 CT[4];
#pragma unroll
    for (int i = 0; i < 4; ++i)
#pragma unroll
        for (int r = 0; r < 16; ++r) CT[i][r] = 0.f;
    float m_carry = 0.f, decay_prev = 0.f, nv = 0.f;
    if (lane < 32) { VEC[V_NP + 0 * 128 + 32 * w + lane] = 0.f; VEC[V_NP + 1 * 128 + 32 * w + lane] = 0.f; VEC[V_NP + 2 * 128 + 32 * w + lane] = 0.f; VEC[V_NP + 3 * 128 + 32 * w + lane] = 0.f; }
#define ML_CHUNK(j) (dir ? 63 - (j) : (j))
#define ML_DMA(cn, bn, LN) do { _Pragma("unroll") for (int i_ = 0; i_ < 4; ++i_) { const int p_ = w * 4 + i_, row_ = 4 * p_ + ((LN) >> 4), ch_ = ((LN) & 15) ^ (((row_ & 3) << 2) | ((row_ >> 2) & 3)); \
        const size_t so_ = (rowbase + 64 * (cn) + row_) * 512 + h * 128 + ch_ * 8; \
        __builtin_amdgcn_global_load_lds((const unsigned*)(QC + so_), (LAS unsigned*)(L + ((half * 2 + (bn)) * 2 + 0) * 16384 + p_ * 1024), 16, 0, 0); \
        __builtin_amdgcn_global_load_lds((const unsigned*)(KC + so_), (LAS unsigned*)(L + ((half * 2 + (bn)) * 2 + 1) * 16384 + p_ * 1024), 16, 0, 0); } } while (0)
#define ML_VLOAD(dst, cn, LN) do { const bf16* vb_ = VF + (size_t)((b * 4 + h) * 64 + (cn)) * 8192 + (size_t)((w * 4) * 64 + (LN)) * 8; _Pragma("unroll") for (int k_ = 0; k_ < 4; ++k_) dst[k_] = *(const bf16x8*)(vb_ + k_ * 512); } while (0)
#define ML_SCAN(cn, pb, LN) do { const int sn_ = dir ? 63 - (LN) : (LN); const float* gp_ = GT + (rowbase + 64 * (cn) + sn_) * 16 + dir * 8 + h; const float gi_ = gp_[0], gfr_ = gp_[4]; \
        float bc_ = fminf(gfr_, 0.f) - log1pf(__expf(-fabsf(gfr_))); \
        _Pragma("unroll") for (int o_ = 1; o_ < 64; o_ <<= 1) { const float t_ = __shfl_up(bc_, o_); if ((LN) >= o_) bc_ += t_; } \
        const float u_ = gi_ - bc_; float pm_ = u_; \
        _Pragma("unroll") for (int o_ = 1; o_ < 64; o_ <<= 1) { const float t_ = __shfl_up(pm_, o_); if ((LN) >= o_) pm_ = fmaxf(pm_, t_); } \
        const float Mt_ = fmaxf(m_carry, pm_), Ml_ = __shfl(Mt_, 63), gt_ = __shfl(bc_, 63); LAS float* sc_ = VEC + V_SCAN + (pb) * 320; \
        sc_[sn_] = __expf(Ml_ - Mt_); sc_[64 + sn_] = __expf(m_carry - Mt_); sc_[128 + sn_] = __expf(u_ - Ml_); sc_[192 + sn_] = __expf(-(bc_ + Mt_)); if ((LN) == 0) sc_[256] = __expf(m_carry - Ml_); \
        m_carry = gt_ + Ml_; } while (0)
    bf16x8 vf[4], vnext[4];
    ML_DMA(ML_CHUNK(0), 0, lane); ML_VLOAD(vnext, ML_CHUNK(0), lane);
    if (w == 3) ML_SCAN(ML_CHUNK(0), 0, lane);
    __syncthreads();
    for (int j = 0; j < 64; ++j) {
        const int cn = ML_CHUNK(j), par = j & 1;
        const LAS unsigned char* Qb = L + ((half * 2 + par) * 2 + 0) * 16384; const LAS unsigned char* Kb = L + ((half * 2 + par) * 2 + 1) * 16384;
        const LAS float* SC = VEC + V_SCAN + par * 320;
#define ML_FRESH() int ln = lane; asm volatile("" : "+v"(ln)); const int r32 = ln & 31, hh = ln >> 5; (void)r32; (void)hh
        if (j + 1 < 64) { ML_FRESH(); ML_DMA(ML_CHUNK(j + 1), par ^ 1, ln); }
        { ML_FRESH();
#pragma unroll
        for (int ks = 0; ks < 4; ++ks) { const f32x4 wa = *(const LAS f32x4*)(SC + 128 + 16 * ks + 4 * hh), wb = *(const LAS f32x4*)(SC + 128 + 16 * ks + 8 + 4 * hh); const v4u raw = __builtin_bit_cast(v4u, vnext[ks]); v4u o;
            o.x = cvtpk(bflo(raw.x) * wa[0], bfhi(raw.x) * wa[1]); o.y = cvtpk(bflo(raw.y) * wa[2], bfhi(raw.y) * wa[3]); o.z = cvtpk(bflo(raw.z) * wb[0], bfhi(raw.z) * wb[1]); o.w = cvtpk(bflo(raw.w) * wb[2], bfhi(raw.w) * wb[3]);
            vf[ks] = __builtin_bit_cast(bf16x8, o); } }
        const float decay = SC[256];
        { ML_FRESH(); if (ln < 32) { nv = decay_prev * nv + ((VEC[V_NP + 32 * w + ln] + VEC[V_NP + 128 + 32 * w + ln]) + (VEC[V_NP + 256 + 32 * w + ln] + VEC[V_NP + 384 + 32 * w + ln])); VEC[V_NVS + 32 * w + ln] = nv; } }
        decay_prev = decay;
        if (w == 3) { if (j + 1 < 64) { ML_FRESH(); ML_SCAN(ML_CHUNK(j + 1), par ^ 1, ln); } }
        else {
            ML_FRESH();
            f32x16 st;
#pragma unroll
            for (int r = 0; r < 16; ++r) st[r] = 0.f;
#pragma unroll 2
            for (int ks = 0; ks < 8; ++ks) { const bf16x8 ka = *(const LAS bf16x8*)(Kb + off_b(32 * sbt + r32, 2 * ks + hh)); const bf16x8 qb = *(const LAS bf16x8*)(Qb + off_b(32 * tbt + r32, 2 * ks + hh)); st = ML_MFMA(ka, qb, st); }
            const float et = SC[32 * tbt + r32]; float dx = 0.f;
#pragma unroll
            for (int r = 0; r < 16; ++r) { const int sl = crow(r, hh); const bool keep = (w == 1) || (dir ? (sl >= r32) : (sl <= r32)); const float x = keep ? st[r] * et : 0.f; st[r] = x; dx += x * SC[128 + 32 * sbt + sl]; }
            dx += __shfl_xor(dx, 32);
            if (hh == 0) VEC[V_DENX + 32 * w + r32] = dx;
            *(LAS bf16x8*)(XCH + (w * 2 + 0) * 1024 + ln * 16) = pack8(st, 0); *(LAS bf16x8*)(XCH + (w * 2 + 1) * 1024 + ln * 16) = pack8(st, 1);
        }
        { ML_FRESH(); float dq = 0.f;
#pragma unroll
          for (int c4 = 0; c4 < 4; ++c4) { const v4u qw = *(const LAS v4u*)(Qb + off_b(ln, 4 * w + c4)); const f32x4 n0 = *(const LAS f32x4*)(VEC + V_NVS + 32 * w + 8 * c4), n1 = *(const LAS f32x4*)(VEC + V_NVS + 32 * w + 8 * c4 + 4);
              dq += bflo(qw.x) * n0[0] + bfhi(qw.x) * n0[1] + bflo(qw.y) * n0[2] + bfhi(qw.y) * n0[3] + bflo(qw.z) * n1[0] + bfhi(qw.z) * n1[1] + bflo(qw.w) * n1[2] + bfhi(qw.w) * n1[3]; }
          VEC[V_DQ + 64 * w + ln] = dq; }
        f32x16 acc0, acc1;
#pragma unroll
        for (int r = 0; r < 16; ++r) { acc0[r] = 0.f; acc1[r] = 0.f; }
#pragma unroll
        for (int db = 0; db < 4; ++db) { ML_FRESH();
#pragma unroll
            for (int k2 = 0; k2 < 2; ++k2) { const bf16x8 cf = pack8(CT[db], k2);
                typedef unsigned u32x2_t __attribute__((ext_vector_type(2)));
                const u32x2_t a0l = *(const LAS u32x2_t*)(Qb + off_b(r32, 4 * db + 2 * k2) + 8 * hh), a0h = *(const LAS u32x2_t*)(Qb + off_b(r32, 4 * db + 2 * k2 + 1) + 8 * hh);
                const u32x2_t a1l = *(const LAS u32x2_t*)(Qb + off_b(32 + r32, 4 * db + 2 * k2) + 8 * hh), a1h = *(const LAS u32x2_t*)(Qb + off_b(32 + r32, 4 * db + 2 * k2 + 1) + 8 * hh);
                const v4u q0 = {a0l.x, a0l.y, a0h.x, a0h.y}, q1 = {a1l.x, a1l.y, a1h.x, a1h.y};
                acc0 = ML_MFMA(__builtin_bit_cast(bf16x8, q0), cf, acc0); acc1 = ML_MFMA(__builtin_bit_cast(bf16x8, q1), cf, acc1); }
            __builtin_amdgcn_sched_barrier(0); }
        __syncthreads();
        { ML_FRESH(); const int tb = ln >> 5, tl = ln & 31; const float dxs = dir ? (tb ? VEC[V_DENX + 64 + tl] : VEC[V_DENX + tl] + VEC[V_DENX + 32 + tl]) : (tb ? VEC[V_DENX + 32 + tl] + VEC[V_DENX + 64 + tl] : VEC[V_DENX + tl]);
          const float dqs = (VEC[V_DQ + ln] + VEC[V_DQ + 64 + ln]) + (VEC[V_DQ + 128 + ln] + VEC[V_DQ + 192 + ln]);
          const float den = SC[64 + ln] * dqs + dxs; VEC[V_RD + 64 * w + ln] = 1.0f / fmaxf(fabsf(den), SC[192 + ln]); }
        { ML_FRESH();
#pragma unroll
        for (int g = 0; g < 4; ++g) { const f32x4 w0 = *(const LAS f32x4*)(SC + 64 + 8 * g + 4 * hh), w1 = *(const LAS f32x4*)(SC + 64 + 32 + 8 * g + 4 * hh);
#pragma unroll
            for (int e = 0; e < 4; ++e) { acc0[4 * g + e] *= w0[e]; acc1[4 * g + e] *= w1[e]; } }
          const bf16x8 x00 = *(const LAS bf16x8*)(XCH + 0 * 1024 + ln * 16), x01 = *(const LAS bf16x8*)(XCH + 1 * 1024 + ln * 16);
          const bf16x8 x10 = *(const LAS bf16x8*)(XCH + 2 * 1024 + ln * 16), x11 = *(const LAS bf16x8*)(XCH + 3 * 1024 + ln * 16);
          const bf16x8 x20 = *(const LAS bf16x8*)(XCH + 4 * 1024 + ln * 16), x21 = *(const LAS bf16x8*)(XCH + 5 * 1024 + ln * 16);
          acc0 = ML_MFMA(x00, vf[0], acc0); acc0 = ML_MFMA(x01, vf[1], acc0);
          acc1 = ML_MFMA(x20, vf[2], acc1); acc1 = ML_MFMA(x21, vf[3], acc1);
          if (dir == 0) { acc1 = ML_MFMA(x10, vf[0], acc1); acc1 = ML_MFMA(x11, vf[1], acc1); }
          else          { acc0 = ML_MFMA(x10, vf[2], acc0); acc0 = ML_MFMA(x11, vf[3], acc0); } }
        { ML_FRESH(); float* hp = HF + (rowbase + 64 * cn) * 512 + h * 128 + 32 * w + r32;
#pragma unroll
          for (int g = 0; g < 4; ++g) { const f32x4 r0 = *(const LAS f32x4*)(VEC + V_RD + 64 * w + 8 * g + 4 * hh), r1 = *(const LAS f32x4*)(VEC + V_RD + 64 * w + 32 + 8 * g + 4 * hh);
#pragma unroll
              for (int e = 0; e < 4; ++e) { const int t = 8 * g + 4 * hh + e; hp[(size_t)t * 512] = acc0[4 * g + e] * r0[e]; hp[(size_t)(32 + t) * 512] = acc1[4 * g + e] * r1[e]; } } }
        if (j + 1 < 64) { ML_FRESH(); ML_VLOAD(vnext, ML_CHUNK(j + 1), ln); }
#pragma unroll
        for (int db = 0; db < 4; ++db) { ML_FRESH();
#pragma unroll
            for (int r = 0; r < 16; ++r) CT[db][r] *= decay;
#pragma unroll
            for (int ks = 0; ks < 4; ++ks) { const int blk = (ln >> 4) & 1, q = (ln & 15) >> 2, p = ln & 3;
                const unsigned a0 = off_b(16 * ks + 0 + 4 * hh + q, 4 * db + 2 * blk + (p >> 1)) + 8 * (p & 1), a1 = off_b(16 * ks + 8 + 4 * hh + q, 4 * db + 2 * blk + (p >> 1)) + 8 * (p & 1);
                const s16x4 lo = __builtin_bit_cast(s16x4, __builtin_amdgcn_ds_read_tr16_b64_v4i16((LAS v4i16_t*)(Kb + a0))), hi = __builtin_bit_cast(s16x4, __builtin_amdgcn_ds_read_tr16_b64_v4i16((LAS v4i16_t*)(Kb + a1)));
                const bf16x8 kt = {lo[0], lo[1], lo[2], lo[3], hi[0], hi[1], hi[2], hi[3]};
                CT[db] = ML_MFMA(kt, vf[ks], CT[db]); }
            __builtin_amdgcn_sched_barrier(0); }
        { ML_FRESH(); float p0 = 0.f, p1 = 0.f;
#pragma unroll
          for (int i = 0; i < 16; ++i) { const int s = 16 * w + i; const unsigned kw = *(const LAS unsigned*)(Kb + off_b(s, ln >> 2) + (ln & 3) * 4); const float ws_ = SC[128 + s]; p0 += ws_ * bflo(kw); p1 += ws_ * bfhi(kw); }
          typedef float f32x2_t __attribute__((ext_vector_type(2))); *(LAS f32x2_t*)(VEC + V_NP + 128 * w + 2 * ln) = (f32x2_t){p0, p1}; }
        __syncthreads();
    }
#undef ML_FRESH
#undef ML_CHUNK
#undef ML_DMA
#undef ML_VLOAD
#undef ML_SCAN
}
}
__device__ __forceinline__ void attn_naive_item(const bf16* Q, const bf16* K, const bf16* V, bf16* Y, int item, int tid) {
    const int b = item >> 6, h = (item >> 3) & 7, seg = item & 7, kvh = h >> 2;
    const size_t row = (size_t)b * SEQ + seg * 512 + tid;
    float q[64], o[64];
    { const v4u* qp = (const v4u*)(Q + row * 512 + h * 64);
#pragma unroll
      for (int i = 0; i < 8; ++i) { const v4u w = qp[i]; q[8 * i] = bflo(w.x); q[8 * i + 1] = bfhi(w.x); q[8 * i + 2] = bflo(w.y); q[8 * i + 3] = bfhi(w.y); q[8 * i + 4] = bflo(w.z); q[8 * i + 5] = bfhi(w.z); q[8 * i + 6] = bflo(w.w); q[8 * i + 7] = bfhi(w.w); } }
#pragma unroll
    for (int d = 0; d < 64; ++d) o[d] = 0.f;
    float m = -1e30f, l = 0.f;
    int z = 0; asm volatile("" : "+v"(z));
    const bf16* Kp = K + (size_t)b * SEQ * 128 + kvh * 64 + z; const bf16* Vp = V + (size_t)b * SEQ * 128 + kvh * 64 + z;
    for (int s = 0; s < SEQ; ++s) {
        const v4u* kr = (const v4u*)(Kp + (size_t)s * 128); float dot = 0.f;
#pragma unroll
        for (int i = 0; i < 8; ++i) { const v4u w = kr[i]; dot += q[8 * i] * bflo(w.x) + q[8 * i + 1] * bfhi(w.x) + q[8 * i + 2] * bflo(w.y) + q[8 * i + 3] * bfhi(w.y) + q[8 * i + 4] * bflo(w.z) + q[8 * i + 5] * bfhi(w.z) + q[8 * i + 6] * bflo(w.w) + q[8 * i + 7] * bfhi(w.w); }
        const float mn = fmaxf(m, dot), corr = exp2f(m - mn), p = exp2f(dot - mn); l = l * corr + p; m = mn;
        const v4u* vr = (const v4u*)(Vp + (size_t)s * 128);
#pragma unroll
        for (int i = 0; i < 8; ++i) { const v4u w = vr[i];
            o[8 * i] = o[8 * i] * corr + p * bflo(w.x); o[8 * i + 1] = o[8 * i + 1] * corr + p * bfhi(w.x); o[8 * i + 2] = o[8 * i + 2] * corr + p * bflo(w.y); o[8 * i + 3] = o[8 * i + 3] * corr + p * bfhi(w.y);
            o[8 * i + 4] = o[8 * i + 4] * corr + p * bflo(w.z); o[8 * i + 5] = o[8 * i + 5] * corr + p * bfhi(w.z); o[8 * i + 6] = o[8 * i + 6] * corr + p * bflo(w.w); o[8 * i + 7] = o[8 * i + 7] * corr + p * bfhi(w.w); }
    }
    const float inv = 1.0f / l; v4u* yp = (v4u*)(Y + row * 1024 + h * 64);
#pragma unroll
    for (int i = 0; i < 8; ++i) { v4u w; w.x = pk2(o[8 * i] * inv, o[8 * i + 1] * inv); w.y = pk2(o[8 * i + 2] * inv, o[8 * i + 3] * inv); w.z = pk2(o[8 * i + 4] * inv, o[8 * i + 5] * inv); w.w = pk2(o[8 * i + 6] * inv, o[8 * i + 7] * inv); yp[i] = w; }
}
__device__ __forceinline__ void mlstm_naive_item(const Args& A, int item, LAS float* lds, int tid) {
    const int b = item >> 3, h = (item >> 1) & 3, dir = item & 1, v = tid >> 2, dq = tid & 3;
    const bf16* QKM = (const bf16*)(A.ws + WS_QKM); const bf16* VM = (const bf16*)(A.ws + WS_VM); const float* GT = (const float*)(A.ws + WS_GATES);
    float* HF = (float*)(A.ws + WS_HF) + (size_t)dir * M * 512; const float* cw = A.in[I_CONVW]; const float* cb = A.in[I_CONVB];
    LAS float* qs = lds; LAS float* ks = lds + 32 * 128; LAS float* vs = lds + 2 * 32 * 128; LAS float* gi = lds + 3 * 32 * 128; LAS float* gf = gi + 32;
    float C[32], n[32]; float m = 0.f;
#pragma unroll
    for (int i = 0; i < 32; ++i) { C[i] = 0.f; n[i] = 0.f; }
    for (int blk = 0; blk < SEQ / 32; ++blk) {
        for (int idx = tid; idx < 32 * 256; idx += NTHREADS) { const int tt = idx >> 8, c = idx & 255, p = blk * 32 + tt, pos = dir ? SEQ - 1 - p : p;
            const int ch = (c < 128) ? h * 128 + c : 512 + h * 128 + (c - 128); float a = cb[ch];
#pragma unroll
            for (int j = 0; j < 5; ++j) { const int pp = pos - 2 + j; if (pp >= 0 && pp < SEQ) a += cw[j * 1024 + ch] * bf2f(QKM[((size_t)b * SEQ + pp) * 1024 + ch]); }
            const float sv = a / (1.0f + expf(-a));
            if (c < 128) qs[tt * 128 + c] = sv; else ks[tt * 128 + c - 128] = sv * 0.08838834764831845f; }
        for (int idx = tid; idx < 32 * 128; idx += NTHREADS) { const int tt = idx >> 7, c = idx & 127, p = blk * 32 + tt, pos = dir ? SEQ - 1 - p : p; vs[tt * 128 + c] = bf2f(VM[((size_t)b * SEQ + pos) * 512 + h * 128 + c]); }
        if (tid < 32) { const int p = blk * 32 + tid, pos = dir ? SEQ - 1 - p : p; const float* gp = GT + ((size_t)b * SEQ + pos) * 16; gi[tid] = gp[dir * 8 + h]; const float f = gp[dir * 8 + 4 + h]; gf[tid] = fminf(f, 0.f) - log1pf(expf(-fabsf(f))); }
        __syncthreads();
        for (int tt = 0; tt < 32; ++tt) {
            const float it = gi[tt], lf = gf[tt], mn = fmaxf(lf + m, it), fg = expf(lf + m - mn), ig = expf(it - mn); m = mn;
            const float vv = vs[tt * 128 + v] * ig; float num = 0.f, den = 0.f;
#pragma unroll
            for (int i4 = 0; i4 < 8; ++i4) { const f32x4 kd = *(const LAS f32x4*)(ks + tt * 128 + dq * 32 + 4 * i4), qd = *(const LAS f32x4*)(qs + tt * 128 + dq * 32 + 4 * i4);
#pragma unroll
                for (int e = 0; e < 4; ++e) { const int i = 4 * i4 + e; C[i] = fg * C[i] + vv * kd[e]; n[i] = fg * n[i] + ig * kd[e]; num += C[i] * qd[e]; den += n[i] * qd[e]; } }
            num += __shfl_xor(num, 1); num += __shfl_xor(num, 2); den += __shfl_xor(den, 1); den += __shfl_xor(den, 2);
            if (dq == 0) { const int p = blk * 32 + tt, pos = dir ? SEQ - 1 - p : p; HF[((size_t)b * SEQ + pos) * 512 + h * 128 + v] = num / fmaxf(fabsf(den), expf(-mn)); }
        }
        __syncthreads();
    }
}
__device__ __forceinline__ void finalize_pass(const Args& A, int lane, int gw, int NGW) {
    const float* H0 = (const float*)(A.ws + WS_HF); const float* H1 = H0 + (size_t)M * 512; const bf16* OM = (const bf16*)(A.ws + WS_OM); bf16* Y = (bf16*)(A.ws + WS_Y);
    const f32x4 g0 = *(const f32x4*)(A.in[I_MNG] + 8 * lane), g1 = *(const f32x4*)(A.in[I_MNG] + 8 * lane + 4);
    for (int row = gw; row < M; row += NGW) {
        const f32x4 a0 = *(const f32x4*)(H0 + (size_t)row * 512 + 8 * lane), a1 = *(const f32x4*)(H0 + (size_t)row * 512 + 8 * lane + 4);
        const f32x4 b0 = *(const f32x4*)(H1 + (size_t)row * 512 + 8 * lane), b1 = *(const f32x4*)(H1 + (size_t)row * 512 + 8 * lane + 4);
        const f32x4 h0 = a0 + b0, h1 = a1 + b1;
        float ss = (h0[0] * h0[0] + h0[1] * h0[1]) + (h0[2] * h0[2] + h0[3] * h0[3]) + (h1[0] * h1[0] + h1[1] * h1[1]) + (h1[2] * h1[2] + h1[3] * h1[3]);
        ss += __shfl_xor(ss, 1); ss += __shfl_xor(ss, 2); ss += __shfl_xor(ss, 4); ss += __shfl_xor(ss, 8);
        const float rstd = 1.0f / sqrtf(ss * (1.0f / 128.0f) + EPS);
        const v4u ow = *(const v4u*)(OM + (size_t)row * 512 + 8 * lane);
        const float og[8] = {bflo(ow.x), bfhi(ow.x), bflo(ow.y), bfhi(ow.y), bflo(ow.z), bfhi(ow.z), bflo(ow.w), bfhi(ow.w)};
        float y[8];
#pragma unroll
        for (int e = 0; e < 4; ++e) { y[e] = h0[e] * rstd * g0[e] / (1.0f + expf(-og[e])); y[4 + e] = h1[e] * rstd * g1[e] / (1.0f + expf(-og[4 + e])); }
        v4u w; w.x = pk2(y[0], y[1]); w.y = pk2(y[2], y[3]); w.z = pk2(y[4], y[5]); w.w = pk2(y[6], y[7]);
        *(v4u*)(Y + (size_t)row * 1024 + 512 + 8 * lane) = w;
    }
}

__global__ void __launch_bounds__(NTHREADS, 2) hymba_fwd(Args args) {
    extern __shared__ __attribute__((aligned(16))) unsigned char lds_raw[];
    LAS unsigned char* lds = (LAS unsigned char*)lds_raw;
    volatile LAS unsigned* MISC = (volatile LAS unsigned*)(lds + MISC_OFF);
    const int tid = threadIdx.x, lane = tid & 63, wave = __builtin_amdgcn_readfirstlane(tid >> 6);
    const int G = gridDim.x, bx = blockIdx.x, vcu = (G % 8 == 0) ? (bx % 8) * (G / 8) + bx / 8 : bx;
    const int gw = vcu * NWAVES + wave, NGW = G * NWAVES;
    unsigned char* ws = args.ws; gu32* ctl = (gu32*)(ws + WS_CTL);
    for (int u = tid; u < (LDS_BYTES - LDSCTL_OFF) / 4; u += NTHREADS) ((LAS unsigned*)(lds + LDSCTL_OFF))[u] = 0u;
    __syncthreads();
    XcdBarrier bar; bar.bar = (unsigned*)(ctl + CW_BAR); bar.x = 0; bar.st = nullptr;
    if (N_LAUNCHES == 1) bar = xcd_barrier_post((unsigned*)(ctl + CW_BAR), MISC + 8);
#define GRID_BAR() do { if (N_LAUNCHES == 1) xcd_barrier(bar); } while (0)
    const int lo = args.ph_lo, hi = args.ph_hi;
#define IN(k) (lo <= (k) && (k) < hi)
#define BOTH(k) (IN(k) && IN((k) + 1))
    bf16* XN = (bf16*)(ws + WS_XN); float* mod = (float*)(ws + WS_MOD);

    if (IN(0)) { p0_prologue(args, lds, tid, lane, wave, vcu, G); if (BOTH(0)) GRID_BAR(); }
    if (IN(1)) { row_pass<0>(args, lane, gw, NGW); if (BOTH(1)) GRID_BAR(); }
    if (IN(2)) {
        gates_pass(args, lane, gw, NGW);
        pg8::Gemm g{XN, (const bf16*)(ws + WS_WIN), M, NPROJ, DMODEL}; pg8::StaticOrder S; S.init(M, NPROJ, G, bx);
        pg8::EpiInProj E{ws};
#if NAIVE_GEMM
        pg8::gemm_simple<pg8::EpiInProj, pg8::StaticOrder>(g, S, E);
#else
        pg8::gemm_phase<pg8::EpiInProj, pg8::StaticOrder, PG8_ALIGN, PG8_SP2>(lds, g, S, E);
#endif
        if (BOTH(2)) GRID_BAR();
    }
    if (IN(3)) { ml::prep_pass(args, lds, tid, bx, G); if (BOTH(3)) GRID_BAR(); }
    if (IN(4)) {
#if NAIVE_MLSTM
        for (int it = bx; it < 64; it += G) mlstm_naive_item(args, it, (LAS float*)lds, tid);
#else
        for (int it = vcu; it < 32; it += G) ml::mlstm_item(args, it, lds, tid);
#endif
#if NAIVE_ATTN
        for (int it = bx; it < 512; it += G) attn_naive_item((const bf16*)(ws + WS_Q), (const bf16*)(ws + WS_K), (const bf16*)(ws + WS_V), (bf16*)(ws + WS_Y), it, tid);
#else
        { const attn_body::AttnTensors AT{(const attn_body::bf16*)(ws + WS_Q), (const attn_body::bf16*)(ws + WS_K), (const attn_body::bf16*)(ws + WS_V), (attn_body::bf16*)(ws + WS_Y)};
          const attn_body::QueueOrder S{(unsigned*)(ctl + CW_QUEUE), (volatile LAS unsigned*)(MISC + 16)}; attn_body::attn_phase<attn_body::QueueOrder>((char*)lds_raw, AT, S); }
#endif
        if (BOTH(4)) GRID_BAR();
    }
    if (IN(5)) { finalize_pass(args, lane, gw, NGW); if (BOTH(5)) GRID_BAR(); }
    if (IN(6)) {
        pg8::Gemm g{(const bf16*)(ws + WS_Y), (const bf16*)(ws + WS_WO), M, DMODEL, DMODEL}; pg8::StaticOrder S; S.init(M, DMODEL, G, bx);
        pg8::EpiResGate E{args.in[I_X], args.out, mod + 2048};
#if NAIVE_GEMM
        pg8::gemm_simple<pg8::EpiResGate, pg8::StaticOrder>(g, S, E);
#else
        pg8::gemm_phase<pg8::EpiResGate, pg8::StaticOrder, PG8_ALIGN, PG8_SP2>(lds, g, S, E);
#endif
        if (BOTH(6)) GRID_BAR();
    }
    if (IN(7)) { row_pass<1>(args, lane, gw, NGW); if (BOTH(7)) GRID_BAR(); }
    if (IN(8)) {
        pg8::Gemm g{XN, (const bf16*)(ws + WS_WGU), M, 2 * FFH, DMODEL}; pg8::StaticOrder S; S.init(M, 2 * FFH, G, bx);
        pg8::EpiSwiGLU E{(bf16*)(ws + WS_ACT)};
#if NAIVE_GEMM
        pg8::gemm_simple<pg8::EpiSwiGLU, pg8::StaticOrder>(g, S, E);
#else
        pg8::gemm_phase<pg8::EpiSwiGLU, pg8::StaticOrder, PG8_ALIGN, PG8_SP2>(lds, g, S, E);
#endif
        if (BOTH(8)) GRID_BAR();
    }
    if (IN(9)) {
        pg8::Gemm g{(const bf16*)(ws + WS_ACT), (const bf16*)(ws + WS_WD), M, DMODEL, FFH}; pg8::StaticOrder S; S.init(M, DMODEL, G, bx);
        pg8::EpiResGate E{args.out, args.out, mod + 5120};
#if NAIVE_GEMM
        pg8::gemm_simple<pg8::EpiResGate, pg8::StaticOrder>(g, S, E);
#else
        pg8::gemm_phase<pg8::EpiResGate, pg8::StaticOrder, PG8_ALIGN, PG8_SP2>(lds, g, S, E);
#endif
        if (BOTH(9)) GRID_BAR();
    }
    if (IN(10)) { row_pass<2>(args, lane, gw, NGW); }
#undef IN
#undef BOTH
}

extern "C" void kernel_launch(void* const* d_in, const int* in_sizes, int n_in, void* d_out, int out_size, void* d_ws, size_t ws_size, hipStream_t stream) {
    static int grid = 0;
    if (grid == 0) {
        if (n_in != 18 || in_sizes[0] != M * DMODEL || out_size != M * DMODEL || ws_size < WS_END) { fprintf(stderr, "kernel_launch: unexpected shapes (n_in %d, in0 %d, out %d, ws %zu < %zu)\n", n_in, n_in > 0 ? in_sizes[0] : -1, out_size, ws_size, (size_t)WS_END); grid = -1; return; }
        int dev = 0, cus = 0, per_cu = 0;
        if (hipGetDevice(&dev) != hipSuccess || hipDeviceGetAttribute(&cus, hipDeviceAttributeMultiprocessorCount, dev) != hipSuccess) { grid = -1; return; }
        if (hipFuncSetAttribute((const void*)hymba_fwd, hipFuncAttributeMaxDynamicSharedMemorySize, LDS_BYTES) != hipSuccess) { fprintf(stderr, "kernel_launch: hipFuncSetAttribute failed\n"); grid = -1; return; }
        if (hipOccupancyMaxActiveBlocksPerMultiprocessor(&per_cu, (const void*)hymba_fwd, NTHREADS, LDS_BYTES) != hipSuccess || per_cu < 1) { fprintf(stderr, "kernel_launch: occupancy query says %d blocks per CU\n", per_cu); (void)hipGetLastError(); grid = -1; return; }
        grid = cus;
    }
    if (grid < 0) return;
    if (hipMemsetAsync((char*)d_ws + WS_CTL, 0, CTL_ZERO_BYTES, stream) != hipSuccess) return;
    Args a{};
    for (int i = 0; i < 18; ++i) a.in[i] = (const float*)d_in[i];
    a.out = (float*)d_out; a.ws = (unsigned char*)d_ws;
    if (N_LAUNCHES == 1) { a.ph_lo = 0; a.ph_hi = NPHASE; hipLaunchKernelGGL(hymba_fwd, dim3(grid), dim3(NTHREADS), LDS_BYTES, stream, a); }
    else for (int p = 0; p < NPHASE; ++p) { a.ph_lo = p; a.ph_hi = p + 1; hipLaunchKernelGGL(hymba_fwd, dim3(grid), dim3(NTHREADS), LDS_BYTES, stream, a); }
}
```

```cpp
#include <hip/hip_runtime.h>
#include <hip/hip_bf16.h>
#include <cstdio>
#include <cstdint>
#include <cmath>
#ifndef NAIVE_GEMM
#define NAIVE_GEMM 0
#endif
#ifndef NAIVE_ATTN
#define NAIVE_ATTN 0
#endif
#ifndef NAIVE_MLSTM
#define NAIVE_MLSTM 0
#endif
#ifndef DUP_PHASE
#define DUP_PHASE (-1)
#endif
#ifndef MK_N_LAUNCHES
#define MK_N_LAUNCHES 1
#endif
constexpr int NWAVES = 8, NTHREADS = NWAVES * 64;
constexpr int BATCH = 8, SEQ = 4096, DMODEL = 1024, M = BATCH * SEQ;
constexpr int NPROJ = 2816, NIN = 2832, FFH = 2816, NMOD = 6144;
constexpr float EPS = 1e-6f;
constexpr int N_LAUNCHES = MK_N_LAUNCHES;
constexpr int NPHASE = 11;
constexpr size_t MiB = 1u << 20;
constexpr size_t WS_CTL = 0, CTL_ZERO_BYTES = 1 * MiB;
constexpr int CW_TMO = 0, CW_CODE = 1, CW_BAR = 4096, CW_QUEUE = 8192;
constexpr size_t WS_MOD = 512 * 1024;
constexpr size_t WS_TABC = 1 * MiB, WS_TABS = 1 * MiB + 4096, WS_QKG = 1 * MiB + 8192, WS_WGT = 1 * MiB + 65536;
constexpr size_t WS_WIN = 2 * MiB, WS_WO = 8 * MiB, WS_WGU = 10 * MiB, WS_WD = 22 * MiB;
constexpr size_t WS_XN = 32 * MiB, WS_Q = 96 * MiB, WS_K = 128 * MiB, WS_V = 136 * MiB, WS_QKM = 144 * MiB, WS_VM = 208 * MiB, WS_OM = 240 * MiB;
constexpr size_t WS_GATES = 272 * MiB, WS_Y = 276 * MiB, WS_HF = 340 * MiB, WS_VF = 468 * MiB, WS_SCN = 500 * MiB, WS_END = 504 * MiB;
constexpr size_t WS_QC = 32 * MiB, WS_KC = 64 * MiB;
constexpr size_t WS_ACT = 96 * MiB;
static_assert(WS_ACT + (size_t)M * FFH * 2 <= WS_GATES, "ACT overlay");
constexpr int RING_BYTES = 131072, LDS_BYTES = 163840, LDSCTL_OFF = LDS_BYTES - 1024, MISC_OFF = LDSCTL_OFF + 320;
#ifdef XB_SPIN_CAP
#undef XB_SPIN_CAP
#endif
#define XB_SPIN_CAP (1u << 26)

namespace pg8 {
#define PG8_LAS __attribute__((address_space(3)))
typedef unsigned short bf16_t;
typedef short bf16x8 __attribute__((ext_vector_type(8)));
typedef float f32x4 __attribute__((ext_vector_type(4)));
typedef unsigned u32x4 __attribute__((ext_vector_type(4)));
constexpr int BM = 256, BK = 64, HALF = 128, HTB = HALF * BK * 2  , STAGE_BYTES = 8 * HTB, NXCD = 8, WGM = 8;

__host__ __device__ __forceinline__ int lds_byte(int r, int c) { const int st = (r >> 4) * 2 + (c >> 5), rr = r & 15, cc = c & 31, ob = rr * 64 + cc * 2; return st * 1024 + (ob ^ (((ob >> 9) & 1) << 5)); }
__host__ __device__ __forceinline__ void stage_rc(int b, int& R, int& C) { const int st = b / 1024, sb = b % 1024, swz = sb ^ (((sb >> 9) & 1) << 5); R = (st >> 1) * 16 + swz / 64; C = (st & 1) * 32 + (swz % 64) / 2; }
__host__ __device__ __forceinline__ int perm32(int rho) { const int n = rho >> 4, i = rho & 15; return 8 * (i >> 2) + 4 * n + (i & 3); }

struct Unit { int pm, pn; };
struct Gemm { const bf16_t* A; const bf16_t* Bt; int M, N, K; };

struct StaticOrder {
    int nM, nN, nwg, G, c;
    __host__ __device__ void init(int M, int N, int G_, int c_) { nM = M / BM; nN = N / BM; nwg = nM * nN; G = G_; c = c_; }
    __host__ __device__ bool next(int i, Unit& u) const {
        const long L = (long)i * G + c; if (L >= nwg) return false;
        int wgid = (int)L; { const int q = nwg / NXCD, r = nwg % NXCD, xcd = wgid % NXCD, off = wgid / NXCD; wgid = (xcd < r ? xcd * (q + 1) : r * (q + 1) + (xcd - r) * q) + off; }
        const int nig = WGM * nN, gid = wgid / nig, fm = gid * WGM, gsz = (nM - fm) < WGM ? (nM - fm) : WGM;
        u.pm = fm + ((wgid % nig) % gsz); u.pn = (wgid % nig) / gsz; return true;
    }
    __device__ __forceinline__ void a_ready(const Unit&) const {}
    __device__ __forceinline__ void done(const Unit&) const {}
};

__device__ __forceinline__ unsigned cvt_pk_bf16(float lo, float hi) { unsigned r; asm volatile("v_cvt_pk_bf16_f32 %0, %1, %2" : "=v"(r) : "v"(lo), "v"(hi)); return r; }
typedef float f32x2 __attribute__((ext_vector_type(2)));
template <class Epi, class Sched, bool ALIGN_EPI = false, bool SP2 = false>
__device__ __forceinline__ void gemm_phase(PG8_LAS unsigned char* lds, const Gemm g, const Sched& S, const Epi& E) {
    const int tid = threadIdx.x, wid = __builtin_amdgcn_readfirstlane(tid >> 6), lane = tid & 63, wr = wid >> 2, wc = wid & 3, fr = lane & 15, fq = lane >> 4;
    const int K = g.K, nt = K / BK;
    unsigned voffA[2], voffB[2];
#pragma unroll
    for (int i = 0; i < 2; ++i) { int R, C; stage_rc(tid * 16 + i * 8192, R, C); const int Rb = Epi::PERM ? ((R & ~31) + perm32(R & 31)) : R;
        voffA[i] = (unsigned)(R * K + C) * 2u; voffB[i] = (unsigned)(Rb * K + C) * 2u; }
    const size_t kstep = (size_t)(BK * 2);
    const size_t hstep = (size_t)HALF * K * 2;
    const size_t tstep = 2 * hstep;
    const unsigned ldsw = (unsigned)wid * 1024u;
    const int aoff = lds_byte(wr * 64 + fr, fq * 8), boff = lds_byte(wc * 32 + fr, fq * 8);
#define PG8_SA(b, h) (((b) * 2 + (h)) * HTB)
#define PG8_SB(b, h) ((4 + (b) * 2 + (h)) * HTB)
#define PG8_STAGE(bufoff, gbase, voff) do { _Pragma("unroll") for (int _i = 0; _i < 2; ++_i) \
        __builtin_amdgcn_global_load_lds((const unsigned*)((const char*)(gbase) + (voff)[_i]), (PG8_LAS unsigned*)(lds + (bufoff) + ldsw + _i * 8192), 16, 0, 0); } while (0)
#define PG8_LDA(dst, b, h) do { _Pragma("unroll") for (int m = 0; m < 4; ++m) _Pragma("unroll") for (int k = 0; k < 2; ++k) dst[m][k] = *(const PG8_LAS bf16x8*)(lds + PG8_SA(b, h) + aoff + m * 2048 + k * 1024); } while (0)
#define PG8_LDB(dst, b, h) do { _Pragma("unroll") for (int n = 0; n < 2; ++n) _Pragma("unroll") for (int k = 0; k < 2; ++k) dst[n][k] = *(const PG8_LAS bf16x8*)(lds + PG8_SB(b, h) + boff + n * 2048 + k * 1024); } while (0)
#define PG8_MMA(ai, bj, At, Bt) do { __builtin_amdgcn_s_setprio(1); _Pragma("unroll") for (int m = 0; m < 4; ++m) _Pragma("unroll") for (int n = 0; n < 2; ++n) _Pragma("unroll") for (int k = 0; k < 2; ++k) \
        acc[ai][bj][m][n] = __builtin_amdgcn_mfma_f32_16x16x32_bf16(Bt[n][k], At[m][k], acc[ai][bj][m][n], 0, 0, 0); __builtin_amdgcn_s_setprio(0); } while (0)
#define PG8_WAIT_V(n) asm volatile("s_waitcnt vmcnt(" #n ")" ::: "memory")
#define PG8_WAIT_L(n) asm volatile("s_waitcnt lgkmcnt(" #n ")" ::: "memory")
#define PG8_BAR __builtin_amdgcn_s_barrier()
#define PG8_SCHED __builtin_amdgcn_sched_barrier(0)
    Unit cur, nxt; int ui = 0;
    if (!S.next(0, cur)) return;
    f32x4 acc[2][2][4][2];
#pragma unroll
    for (int a = 0; a < 2; ++a)
#pragma unroll
        for (int b = 0; b < 2; ++b)
#pragma unroll
            for (int m = 0; m < 4; ++m)
#pragma unroll
                for (int n = 0; n < 2; ++n) acc[a][b][m][n] = (f32x4){0.f, 0.f, 0.f, 0.f};
    bf16x8 At[4][2], B0[2][2], B1[2][2];
    const char* cA = (const char*)g.A + (size_t)cur.pm * tstep; const char* cB = (const char*)g.Bt + (size_t)cur.pn * tstep;
    S.a_ready(cur);
    if constexpr (SP2) {
        PG8_STAGE(PG8_SB(0, 0), cB, voffB); PG8_STAGE(PG8_SB(0, 1), cB + hstep, voffB); PG8_STAGE(PG8_SA(0, 0), cA, voffA); PG8_STAGE(PG8_SA(0, 1), cA + hstep, voffA);
        if (wr == 1) PG8_BAR;
        PG8_WAIT_V(2); PG8_BAR;
        PG8_STAGE(PG8_SB(1, 0), cB + kstep, voffB); PG8_STAGE(PG8_SA(1, 0), cA + kstep, voffA); PG8_STAGE(PG8_SB(1, 1), cB + hstep + kstep, voffB);
        PG8_WAIT_V(6); PG8_BAR;
    } else {
        PG8_STAGE(PG8_SB(0, 0), cB, voffB); PG8_STAGE(PG8_SA(0, 0), cA, voffA); PG8_STAGE(PG8_SB(0, 1), cB + hstep, voffB); PG8_STAGE(PG8_SA(0, 1), cA + hstep, voffA);
        if (wr == 1) PG8_BAR;
        PG8_WAIT_V(4); PG8_BAR;
        PG8_STAGE(PG8_SB(1, 0), cB + kstep, voffB); PG8_STAGE(PG8_SA(1, 0), cA + kstep, voffA); PG8_STAGE(PG8_SB(1, 1), cB + hstep + kstep, voffB);
        PG8_WAIT_V(6); PG8_BAR;
    }
    for (;;) {
        const bool has_next = S.next(ui + 1, nxt);
        const char* nA = has_next ? (const char*)g.A + (size_t)nxt.pm * tstep : cA; const char* nB = has_next ? (const char*)g.Bt + (size_t)nxt.pn * tstep : cB;
        for (int t = 0; t < nt; t += 2) {
            const bool last = (t == nt - 2);
            const char* a1 = cA + (size_t)(t + 1) * kstep;
            const char* a2 = last ? nA : cA + (size_t)(t + 2) * kstep; const char* b2 = last ? nB : cB + (size_t)(t + 2) * kstep;
            const char* a3 = a2 + kstep; const char* b3 = b2 + kstep;
            if (last && has_next) S.a_ready(nxt);
            if constexpr (SP2) {
            PG8_LDB(B0, 0, 0); PG8_LDB(B1, 0, 1); PG8_SCHED; PG8_LDA(At, 0, 0); PG8_STAGE(PG8_SA(1, 1), a1 + hstep, voffA);
            PG8_WAIT_V(8); PG8_WAIT_L(0); PG8_BAR; PG8_MMA(0, 0, At, B0); PG8_MMA(0, 1, At, B1); PG8_BAR; PG8_SCHED;
            PG8_LDA(At, 0, 1); PG8_STAGE(PG8_SB(0, 0), b2, voffB); PG8_STAGE(PG8_SB(0, 1), b2 + hstep, voffB); PG8_STAGE(PG8_SA(0, 0), a2, voffA);
            PG8_WAIT_V(8); PG8_WAIT_L(0); PG8_BAR; PG8_MMA(1, 0, At, B0); PG8_MMA(1, 1, At, B1); PG8_BAR; PG8_SCHED;
            PG8_LDB(B0, 1, 0); PG8_LDB(B1, 1, 1); PG8_SCHED; PG8_LDA(At, 1, 0); PG8_STAGE(PG8_SA(0, 1), a2 + hstep, voffA);
            PG8_WAIT_V(8); PG8_WAIT_L(0); PG8_BAR; PG8_MMA(0, 0, At, B0); PG8_MMA(0, 1, At, B1); PG8_BAR; PG8_SCHED;
            PG8_LDA(At, 1, 1); PG8_STAGE(PG8_SB(1, 0), b3, voffB); PG8_STAGE(PG8_SB(1, 1), b3 + hstep, voffB); PG8_STAGE(PG8_SA(1, 0), a3, voffA);
            PG8_WAIT_V(8); PG8_WAIT_L(0); PG8_BAR; PG8_MMA(1, 0, At, B0); PG8_MMA(1, 1, At, B1); PG8_BAR; PG8_SCHED;
            } else {
            PG8_LDB(B0, 0, 0); PG8_SCHED; PG8_LDA(At, 0, 0); PG8_STAGE(PG8_SA(1, 1), a1 + hstep, voffA);
            PG8_WAIT_L(8); PG8_BAR; PG8_WAIT_L(0); PG8_MMA(0, 0, At, B0); PG8_BAR; PG8_SCHED;
            PG8_LDB(B1, 0, 1); PG8_STAGE(PG8_SB(0, 0), b2, voffB);
            PG8_BAR; PG8_WAIT_L(0); PG8_MMA(0, 1, At, B1); PG8_BAR;
            PG8_LDA(At, 0, 1); PG8_STAGE(PG8_SA(0, 0), a2, voffA);
            PG8_BAR; PG8_WAIT_L(0); PG8_MMA(1, 0, At, B0); PG8_BAR; PG8_SCHED;
            PG8_STAGE(PG8_SB(0, 1), b2 + hstep, voffB);
            PG8_WAIT_V(6); PG8_BAR; PG8_MMA(1, 1, At, B1); PG8_BAR;
            PG8_LDB(B0, 1, 0); PG8_SCHED; PG8_LDA(At, 1, 0); PG8_STAGE(PG8_SA(0, 1), a2 + hstep, voffA);
            PG8_WAIT_L(8); PG8_BAR; PG8_WAIT_L(0); PG8_MMA(0, 0, At, B0); PG8_BAR; PG8_SCHED;
            PG8_LDB(B1, 1, 1); PG8_STAGE(PG8_SB(1, 0), b3, voffB);
            PG8_BAR; PG8_WAIT_L(0); PG8_MMA(0, 1, At, B1); PG8_BAR;
            PG8_LDA(At, 1, 1); PG8_STAGE(PG8_SA(1, 0), a3, voffA);
            PG8_BAR; PG8_WAIT_L(0); PG8_MMA(1, 0, At, B0); PG8_BAR; PG8_SCHED;
            PG8_STAGE(PG8_SB(1, 1), b3 + hstep, voffB);
            PG8_WAIT_V(6); PG8_BAR; PG8_MMA(1, 1, At, B1); PG8_BAR;
            }
        }
        if constexpr (ALIGN_EPI) { if (wr == 0) PG8_BAR; }
        if constexpr (!Epi::AFTER_DRAIN) { E(acc, cur, wr, wc, fr, fq); S.done(cur); }
        if (!has_next) break;
#pragma unroll
        for (int a = 0; a < 2; ++a)
#pragma unroll
            for (int b = 0; b < 2; ++b)
#pragma unroll
                for (int m = 0; m < 4; ++m)
#pragma unroll
                    for (int n = 0; n < 2; ++n) acc[a][b][m][n] = (f32x4){0.f, 0.f, 0.f, 0.f};
        cur = nxt; cA = nA; cB = nB; ++ui;
        if constexpr (ALIGN_EPI) { if (wr == 1) PG8_BAR; }
    }
    PG8_WAIT_V(0);
    if constexpr (!ALIGN_EPI) { if (wr == 0) PG8_BAR; }
    PG8_BAR;
    if constexpr (Epi::AFTER_DRAIN) { E.fused(acc, cur, wr, wc, fr, fq, lds, wid, lane); S.done(cur); }
#undef PG8_SA
#undef PG8_SB
#undef PG8_STAGE
#undef PG8_LDA
#undef PG8_LDB
#undef PG8_MMA
#undef PG8_WAIT_V
#undef PG8_WAIT_L
#undef PG8_BAR
#undef PG8_SCHED
}
typedef unsigned u32x2 __attribute__((ext_vector_type(2)));
constexpr float ATT_C2 = 0.125f * 1.4426950408889634f;
struct EpiInProj {
    static constexpr bool PERM = false, AFTER_DRAIN = false;
    unsigned char* ws;
    __device__ __forceinline__ void operator()(const f32x4 (&acc)[2][2][4][2], const Unit& u, int wr, int wc, int fr, int fq) const {
        const int pn = u.pn, row0 = u.pm * BM + wr * 64 + fr;
        if (pn >= 3) {
            const size_t boff = (pn < 7) ? WS_QKM : ((pn < 9) ? WS_VM : WS_OM);
            const int ldc = (pn < 7) ? 1024 : 512, c0 = 256 * ((pn < 7) ? (pn - 3) : ((pn < 9) ? (pn - 7) : (pn - 9))) + wc * 32 + 8 * fq;
            bf16_t* base = (bf16_t*)(ws + boff);
#pragma unroll
            for (int ai = 0; ai < 2; ++ai)
#pragma unroll
                for (int m = 0; m < 4; ++m) { bf16_t* rowp = base + (size_t)(row0 + ai * HALF + m * 16) * ldc + c0;
#pragma unroll
                    for (int bj = 0; bj < 2; ++bj) { const f32x4 v0 = acc[ai][bj][m][0], v1 = acc[ai][bj][m][1]; u32x4 w;
                        w.x = cvt_pk_bf16(v0[0], v0[1]); w.y = cvt_pk_bf16(v0[2], v0[3]); w.z = cvt_pk_bf16(v1[0], v1[1]); w.w = cvt_pk_bf16(v1[2], v1[3]);
                        *(u32x4*)(rowp + bj * HALF) = w; } }
            return;
        }
        const bool isv = (pn == 2 && wc >= 2), isq = (pn < 2);
        const size_t boff = isq ? WS_Q : (isv ? WS_V : WS_K);
        const int ldc = isq ? 512 : 128, hcol = isq ? (4 * pn + wc) * 64 : (wc & 1) * 64;
        bf16_t* base = (bf16_t*)(ws + boff);
        const float* g = (const float*)(ws + WS_QKG) + (isq ? 0 : 64);
        const float* tabc = (const float*)(ws + WS_TABC); const float* tabs = (const float*)(ws + WS_TABS);
        f32x4 gv[4];
#pragma unroll
        for (int dq = 0; dq < 4; ++dq) gv[dq] = *(const f32x4*)(g + 16 * dq + 4 * fq);
        const float osc = isq ? ATT_C2 : 1.0f;
#pragma unroll
        for (int ai = 0; ai < 2; ++ai)
#pragma unroll
            for (int m = 0; m < 4; ++m) {
                const int r = row0 + ai * HALF + m * 16;
                f32x4 y[4];
#pragma unroll
                for (int dq = 0; dq < 4; ++dq) y[dq] = acc[ai][dq >> 1][m][dq & 1];
                if (!isv) {
                    float ss = 0.f;
#pragma unroll
                    for (int dq = 0; dq < 4; ++dq) ss += (y[dq][0] * y[dq][0] + y[dq][1] * y[dq][1]) + (y[dq][2] * y[dq][2] + y[dq][3] * y[dq][3]);
                    ss += __shfl_xor(ss, 16); ss += __shfl_xor(ss, 32);
                    const float rstd = 1.0f / sqrtf(ss * (1.0f / 64.0f) + 1e-6f);
#pragma unroll
                    for (int dq = 0; dq < 4; ++dq) y[dq] = y[dq] * rstd * gv[dq];
                    const int t = r & 4095, pr = t >> 6, pc = t & 63;
                    const f32x4 cr = *(const f32x4*)(tabc + pr * 16 + 4 * fq), sr = *(const f32x4*)(tabs + pr * 16 + 4 * fq);
                    const f32x4 cc = *(const f32x4*)(tabc + pc * 16 + 4 * fq), sc = *(const f32x4*)(tabs + pc * 16 + 4 * fq);
                    const f32x4 o0 = y[0] * cr - y[1] * sr, o1 = y[1] * cr + y[0] * sr, o2 = y[2] * cc - y[3] * sc, o3 = y[3] * cc + y[2] * sc;
                    y[0] = o0 * osc; y[1] = o1 * osc; y[2] = o2 * osc; y[3] = o3 * osc;
                }
                bf16_t* rowp = base + (size_t)r * ldc + hcol + 4 * fq;
#pragma unroll
                for (int dq = 0; dq < 4; ++dq) { u32x2 w; w.x = cvt_pk_bf16(y[dq][0], y[dq][1]); w.y = cvt_pk_bf16(y[dq][2], y[dq][3]); *(u32x2*)(rowp + 16 * dq) = w; }
            }
    }
};
struct EpiResGate {
    static constexpr bool PERM = false, AFTER_DRAIN = false;
    const float* base; float* out; const float* gate;
    __device__ __forceinline__ void operator()(const f32x4 (&acc)[2][2][4][2], const Unit& u, int wr, int wc, int fr, int fq) const {
        const int row0 = u.pm * BM + wr * 64 + fr, col0 = u.pn * BM + wc * 32 + 4 * fq, b = (u.pm * BM) >> 12;
        f32x4 gv[2][2];
#pragma unroll
        for (int bj = 0; bj < 2; ++bj)
#pragma unroll
            for (int n = 0; n < 2; ++n) gv[bj][n] = *(const f32x4*)(gate + (size_t)b * 6144 + col0 + bj * HALF + n * 16);
#pragma unroll
        for (int ai = 0; ai < 2; ++ai)
#pragma unroll
            for (int m = 0; m < 4; ++m) { const size_t off = (size_t)(row0 + ai * HALF + m * 16) * 1024 + col0;
#pragma unroll
                for (int bj = 0; bj < 2; ++bj)
#pragma unroll
                    for (int n = 0; n < 2; ++n) { const f32x4 bs = *(const f32x4*)(base + off + bj * HALF + n * 16); *(f32x4*)(out + off + bj * HALF + n * 16) = bs + gv[bj][n] * acc[ai][bj][m][n]; } }
    }
};
struct EpiSwiGLU {
    static constexpr bool PERM = false, AFTER_DRAIN = false;
    bf16_t* act;
    __device__ __forceinline__ void operator()(const f32x4 (&acc)[2][2][4][2], const Unit& u, int wr, int wc, int fr, int fq) const {
        const int row0 = u.pm * BM + wr * 64 + fr, c0 = u.pn * HALF + wc * 32 + 8 * fq;
#pragma unroll
        for (int ai = 0; ai < 2; ++ai)
#pragma unroll
            for (int m = 0; m < 4; ++m) { float o[8];
#pragma unroll
                for (int n = 0; n < 2; ++n)
#pragma unroll
                    for (int e = 0; e < 4; ++e) { const float gt = acc[ai][0][m][n][e], up = acc[ai][1][m][n][e];
                        o[4 * n + e] = gt * __builtin_amdgcn_rcpf(1.0f + __builtin_amdgcn_exp2f(-1.4426950408889634f * gt)) * up; }
                u32x4 w; w.x = cvt_pk_bf16(o[0], o[1]); w.y = cvt_pk_bf16(o[2], o[3]); w.z = cvt_pk_bf16(o[4], o[5]); w.w = cvt_pk_bf16(o[6], o[7]);
                *(u32x4*)(act + (size_t)(row0 + ai * HALF + m * 16) * 2816 + c0) = w; }
    }
};
template <class Epi, class Sched>
__device__ __forceinline__ void gemm_simple(const Gemm g, const Sched& S, const Epi& E) {
    const int tid = threadIdx.x, wid = __builtin_amdgcn_readfirstlane(tid >> 6), lane = tid & 63, wr = wid >> 2, wc = wid & 3, fr = lane & 15, fq = lane >> 4;
    const int K = g.K; Unit u;
    for (int i = 0; S.next(i, u); ++i) {
        f32x4 acc[2][2][4][2];
#pragma unroll
        for (int a = 0; a < 2; ++a)
#pragma unroll
            for (int b = 0; b < 2; ++b)
#pragma unroll
                for (int m = 0; m < 4; ++m)
#pragma unroll
                    for (int n = 0; n < 2; ++n) acc[a][b][m][n] = (f32x4){0.f, 0.f, 0.f, 0.f};
        const bf16_t* Ab = g.A + (size_t)(u.pm * BM + wr * 64 + fr) * K + fq * 8;
        const bf16_t* Bb = g.Bt + (size_t)(u.pn * BM + wc * 32 + fr) * K + fq * 8;
        for (int k0 = 0; k0 < K; k0 += 32) {
            bf16x8 a[2][4], b[2][2];
#pragma unroll
            for (int ai = 0; ai < 2; ++ai)
#pragma unroll
                for (int m = 0; m < 4; ++m) a[ai][m] = *(const bf16x8*)(Ab + (size_t)(ai * HALF + m * 16) * K + k0);
#pragma unroll
            for (int bj = 0; bj < 2; ++bj)
#pragma unroll
                for (int n = 0; n < 2; ++n) b[bj][n] = *(const bf16x8*)(Bb + (size_t)(bj * HALF + n * 16) * K + k0);
#pragma unroll
            for (int ai = 0; ai < 2; ++ai)
#pragma unroll
                for (int bj = 0; bj < 2; ++bj)
#pragma unroll
                    for (int m = 0; m < 4; ++m)
#pragma unroll
                        for (int n = 0; n < 2; ++n) acc[ai][bj][m][n] = __builtin_amdgcn_mfma_f32_16x16x32_bf16(b[bj][n], a[ai][m], acc[ai][bj][m][n], 0, 0, 0);
        }
        E(acc, u, wr, wc, fr, fq);
    }
}
}
#ifndef PG8_SP2
#define PG8_SP2 true
#endif
#ifndef PG8_ALIGN
#define PG8_ALIGN true
#endif
#include <hip/hip_bf16.h>
#include <cmath>
namespace attn_body {
using bf16=__hip_bfloat16;
using bf16x8=__attribute__((ext_vector_type(8)))short;
using s16x4=__attribute__((ext_vector_type(4)))short;
using f32x16=__attribute__((ext_vector_type(16)))float;
using u32x4=__attribute__((ext_vector_type(4)))unsigned;
constexpr int BATCH=8,NHEAD=8,NKV=2,SEQ=4096,D=64,QP=512,KP=128,OP=1024;
constexpr int NW=8,QBLK=32,QB=QBLK*NW,KVBLK=64,NQB=SEQ/QB;
constexpr int ATTN_UNIT_ROWS=QB;
__device__ __forceinline__ int crow(int r,int hi){return (r&3)+8*(r>>2)+4*hi;}
#define SBAR() __builtin_amdgcn_sched_barrier(0)
__device__ __forceinline__ void cmask(f32x16&p0,f32x16&p1,int jb,int qrel,int hi){
  const float NEG=-INFINITY; int kb=64*jb+4*hi;
  #pragma unroll
  for(int r=0;r<16;++r){int kv=kb+(r&3)+8*(r>>2); if(kv>qrel)p0[r]=NEG; if(kv+32>qrel)p1[r]=NEG;}
}

constexpr int NSLOT=3, SLOTB=8192;
constexpr int LDS_K=0, LDS_V=NSLOT*SLOTB, LDS_WS=2*NSLOT*SLOTB, LDS_OST=LDS_WS+NW*64*4, LDS_BYTES=LDS_OST+NW*4096;
constexpr float C2=0.125f*1.4426950408889634f;
__device__ __forceinline__ void glds16(const void*gsrc,unsigned lds_dst){unsigned keep;
  asm volatile("s_mov_b32 %0, m0\n\ts_mov_b32 m0, %2\n\ts_nop 0\n\tglobal_load_lds_dwordx4 %1, off\n\ts_mov_b32 m0, %0":"=&s"(keep):"v"(gsrc),"s"(lds_dst):"memory");}
__device__ __forceinline__ float max3f(float a,float b,float c){float r;asm("v_max3_f32 %0, %1, %2, %3":"=v"(r):"v"(a),"v"(b),"v"(c));return r;}
__device__ __forceinline__ float max2f(float a,float b){float r;asm("v_max_f32_e32 %0, %1, %2":"=v"(r):"v"(a),"v"(b));return r;}
__device__ __forceinline__ float fadd_s(float a,float b){float r;asm("v_add_f32_e32 %0, %1, %2":"=v"(r):"v"(a),"v"(b));return r;}
__device__ __forceinline__ float fsub_s(float a,float b){float r;asm("v_sub_f32_e32 %0, %1, %2":"=v"(r):"v"(a),"v"(b));return r;}
typedef float f32x2_t __attribute__((ext_vector_type(2))); typedef __bf16 bf16x2_t __attribute__((ext_vector_type(2)));
__device__ __forceinline__ unsigned cvtpk_s(float lo,float hi){f32x2_t v={lo,hi};bf16x2_t b=__builtin_convertvector(v,bf16x2_t);return __builtin_bit_cast(unsigned,b);}
#define WAIT_BAR(N) asm volatile("s_waitcnt vmcnt(" #N ") lgkmcnt(0)\n\ts_barrier":::"memory")

__device__ __forceinline__ void qkt(f32x16&p0,f32x16&p1,const char*Kslot,const bf16x8*qr,const f32x16&negm,int r32,int hi){
  const char*kb=Kslot+hi*1024+r32*16;
  #pragma unroll
  for(int d0=0;d0<4;++d0){
    const bf16x8 b0=*reinterpret_cast<const bf16x8*>(kb+d0*2048);
    const bf16x8 b1=*reinterpret_cast<const bf16x8*>(kb+d0*2048+512);
    if(d0==0){p0=__builtin_amdgcn_mfma_f32_32x32x16_bf16(b0,qr[0],negm,0,0,0);p1=__builtin_amdgcn_mfma_f32_32x32x16_bf16(b1,qr[0],negm,0,0,0);}
    else{p0=__builtin_amdgcn_mfma_f32_32x32x16_bf16(b0,qr[d0],p0,0,0,0);p1=__builtin_amdgcn_mfma_f32_32x32x16_bf16(b1,qr[d0],p1,0,0,0);}}
}
typedef __attribute__((address_space(3))) const char* lds_cptr;
typedef short v4i16_t __attribute__((ext_vector_type(4)));
__device__ __forceinline__ void kload8(bf16x8*kf,lds_cptr kp){
  kf[0]=*(const __attribute__((address_space(3))) bf16x8*)(kp);      kf[1]=*(const __attribute__((address_space(3))) bf16x8*)(kp+512);
  kf[2]=*(const __attribute__((address_space(3))) bf16x8*)(kp+2048); kf[3]=*(const __attribute__((address_space(3))) bf16x8*)(kp+2560);
  kf[4]=*(const __attribute__((address_space(3))) bf16x8*)(kp+4096); kf[5]=*(const __attribute__((address_space(3))) bf16x8*)(kp+4608);
  kf[6]=*(const __attribute__((address_space(3))) bf16x8*)(kp+6144); kf[7]=*(const __attribute__((address_space(3))) bf16x8*)(kp+6656);
}
__device__ __forceinline__ void kload2(bf16x8*kf,lds_cptr kp,int j){ kf[2*j]=*(const __attribute__((address_space(3))) bf16x8*)(kp+j*2048); kf[2*j+1]=*(const __attribute__((address_space(3))) bf16x8*)(kp+j*2048+512); }
__device__ __forceinline__ s16x4 vtr(lds_cptr p){ return __builtin_bit_cast(s16x4,__builtin_amdgcn_ds_read_tr16_b64_v4i16((__attribute__((address_space(3))) v4i16_t*)p)); }
__device__ __forceinline__ float rowmax(const f32x16&p0,const f32x16&p1){
  float a=max3f(p0[0],p0[1],p1[0]),b=max3f(p0[2],p0[3],p1[1]);a=max3f(a,p1[2],p1[3]);
  #pragma unroll
  for(int r=4;r<16;r+=4){a=max3f(a,p0[r],p0[r+1]);b=max3f(b,p0[r+2],p0[r+3]);a=max3f(a,p1[r],p1[r+1]);b=max3f(b,p1[r+2],p1[r+3]);}
  const float m=max2f(a,b);
  auto rr=__builtin_amdgcn_permlane32_swap(__float_as_uint(m),__float_as_uint(m),false,false);
  return max2f(__uint_as_float(rr[0]),__uint_as_float(rr[1]));
}
__device__ __forceinline__ void pv(f32x16*o,int vb,bf16x8 pa0,bf16x8 pa1,bf16x8 pa2,bf16x8 pa3){
  #pragma unroll
  for(int d0=0;d0<2;++d0){s16x4 lo[4],hi[4];
    #pragma unroll
    for(int ks=0;ks<4;++ks){
      asm volatile("ds_read_b64_tr_b16 %0,%1 offset:%c2":"=&v"(lo[ks]):"v"(vb),"i"(d0*4096+ks*1024):"memory");
      asm volatile("ds_read_b64_tr_b16 %0,%1 offset:%c2":"=&v"(hi[ks]):"v"(vb),"i"(d0*4096+ks*1024+512):"memory");}
    asm volatile("s_waitcnt lgkmcnt(0)":::"memory");SBAR();
    #define PK(k) (bf16x8){lo[k][0],lo[k][1],lo[k][2],lo[k][3],hi[k][0],hi[k][1],hi[k][2],hi[k][3]}
    o[d0]=__builtin_amdgcn_mfma_f32_32x32x16_bf16(pa0,PK(0),o[d0],0,0,0);
    o[d0]=__builtin_amdgcn_mfma_f32_32x32x16_bf16(pa1,PK(1),o[d0],0,0,0);
    o[d0]=__builtin_amdgcn_mfma_f32_32x32x16_bf16(pa2,PK(2),o[d0],0,0,0);
    o[d0]=__builtin_amdgcn_mfma_f32_32x32x16_bf16(pa3,PK(3),o[d0],0,0,0);
    #undef PK
  }
}

#ifndef ATTN_STORE16
#define ATTN_STORE16(p,v) (*(u32x4*)(p)=(v))
#endif
template<int THRL> __device__ __forceinline__ void attn_unit(int b,int h,int qb,const bf16*Q,const bf16*__restrict__ K,const bf16*__restrict__ V,bf16*O,char*shm){
  const int tid=threadIdx.x,lane=tid&63,r32=lane&31,hi=lane>>5; const int wid=__builtin_amdgcn_readfirstlane(tid>>6);
  const long rowbase=(long)b*SEQ; const int q0=qb*QB;
  const bf16*Qw=Q+(rowbase+q0+wid*QBLK)*QP+h*D;
  const int kvh=h/(NHEAD/NKV); const bf16*Kh=K+rowbase*KP+kvh*D,*Vh=V+rowbase*KP+kvh*D;
  const unsigned lds0=(unsigned)(uintptr_t)shm;
  float*wsf=(float*)(shm+LDS_WS)+wid*64;
  const bf16*ksrc=Kh+(long)lane*KP+wid*8;
  const bf16*vsrc=Vh+(long)(16*(wid&3)+(lane>>2))*KP+(wid>>2)*32+(lane&3)*8;
  const unsigned kdst=lds0+LDS_K+wid*1024, vdst=lds0+LDS_V+wid*1024;
  #define DMA_K(t,slot) glds16(ksrc+(long)(t)*KVBLK*KP,(unsigned)__builtin_amdgcn_readfirstlane(kdst+(slot)))
  #define DMA_V(t,slot) glds16(vsrc+(long)(t)*KVBLK*KP,(unsigned)__builtin_amdgcn_readfirstlane(vdst+(slot)))
  const int vb0=(int)(lds0+LDS_V)+((lane>>4)&1)*32+(lane&3)*8+(4*hi+((lane&15)>>2))*64;
  const char*Kbase=shm+LDS_K; bf16x8 kf[8];
  const lds_cptr shm3=(lds_cptr)shm; const lds_cptr kp0=shm3+LDS_K+hi*1024+r32*16; const lds_cptr vp0=shm3+LDS_V+((lane>>4)&1)*32+(lane&3)*8+(4*hi+((lane&15)>>2))*64;
  const int NT=SEQ/KVBLK;
  DMA_K(0,0);DMA_V(0,0);DMA_K(1,SLOTB);
  bf16x8 qr[4];
  #pragma unroll
  for(int d0=0;d0<4;++d0)qr[d0]=*reinterpret_cast<const bf16x8*>(&Qw[(long)r32*QP+d0*16+hi*8]);
  float mhat=0.f,l_reg=0.f;f32x16 o[2];o[0]=f32x16{};o[1]=f32x16{};f32x16 negm=f32x16{};asm volatile("":"+v"(negm));
  const int qrel=wid*QBLK+r32;
  #define CMASK(P0,P1,t) do{}while(0)
  bool resc=false;
  #define START(P0,P1) do{ const float rm=rowmax(P0,P1); resc=false; \
    { const float dl=rm; mhat=fadd_s(mhat,dl); \
      _Pragma("unroll") for(int r=0;r<16;++r){P0[r]=fsub_s(P0[r],dl);P1[r]=fsub_s(P1[r],dl);} \
      _Pragma("unroll") for(int r=0;r<16;++r)negm[r]=-mhat; asm volatile("":"+v"(negm)); } \
    _Pragma("unroll") for(int r=0;r<16;++r)P0[r]=__builtin_amdgcn_exp2f(P0[r]); }while(0)
  #define RESC() do{ if(resc){ asm volatile("s_waitcnt lgkmcnt(0)":::"memory"); \
      _Pragma("unroll") for(int d_=0;d_<2;++d_) _Pragma("unroll") for(int r=0;r<16;++r)o[d_][r]*=wsf[crow(r,hi)]; } }while(0)
  f32x16 pA0,pA1,pB0,pB1;
  int sl_prev=0,sl_cur=0,sl_next=SLOTB;
  #define ROT() do{sl_prev=sl_cur;sl_cur=sl_next;sl_next=(sl_next==(NSLOT-1)*SLOTB)?0:sl_next+SLOTB;}while(0)
  DMA_K(2,2*SLOTB);
  WAIT_BAR(3);
  qkt(pA0,pA1,Kbase,qr,negm,r32,hi);asm volatile("s_nop 15\n\ts_nop 7":"+v"(pA0),"+v"(pA1));CMASK(pA0,pA1,0);
  START(pA0,pA1);
  _Pragma("unroll") for(int r=0;r<16;++r)pA1[r]=__builtin_amdgcn_exp2f(pA1[r]);
  WAIT_BAR(0);
  DMA_K(3,0);DMA_V(1,SLOTB);
  ROT();
  kload8(kf,kp0+sl_cur);
  WAIT_BAR(2);
  s16x4 vlo[8],vhi[8]; u32x4 pw0,pw1,pw2,pw3;
  #define PKW(P,B) cvtpk_s(P[B],P[B+1])
  #define PAF(k) __builtin_bit_cast(bf16x8,pw##k)
  #define VFR(i) (bf16x8){vlo[i][0],vlo[i][1],vlo[i][2],vlo[i][3],vhi[i][0],vhi[i][1],vhi[i][2],vhi[i][3]}
  #define PIN(x) asm volatile("":"+v"(x))
  #define MX3(a,b,c) __builtin_fmaxf(__builtin_fmaxf((a),(b)),(c))
  #define GAPA(MF,A0,A1,A2,A3,W0,W1,PW) do{ MF; sacc+=A0; sacc+=A1; sacc+=A2; sacc+=A3; PIN(sacc); W0; W1; PIN(PW); SBAR(); }while(0)
  #define EX(v) __builtin_amdgcn_exp2f(v)
  #define GAPB(MF,X,B) do{ MF; X[B]=EX(X[B]); X[B+1]=EX(X[B+1]); X[B+2]=EX(X[B+2]); X[B+3]=EX(X[B+3]); PIN(X); SBAR(); }while(0)
  #define VRD(i) do{ vlo[i]=vtr(vp_+(((i)>>2)*4096+((i)&3)*1024)); vhi[i]=vtr(vp_+(((i)>>2)*4096+((i)&3)*1024+512)); }while(0)
  #define KRD(G,j) do{ if(G){ kload2(kf,kp0+sl_next,j); SBAR(); } }while(0)
  #define STEP(C0,C1,P0,P1,t,GK,GV,GL) do{ SBAR(); \
    const lds_cptr vp_=vp0+sl_prev; \
    VRD(0); SBAR(); float sacc=(P0[0]+P0[1]); \
    GAPA(C0=__builtin_amdgcn_mfma_f32_32x32x16_bf16(kf[0],qr[0],negm,0,0,0), P0[2],P0[3],P0[4],P0[5],     pw0[0]=PKW(P0,0), pw0[1]=PKW(P0,2), pw0); \
    VRD(4); SBAR(); GAPA(C1=__builtin_amdgcn_mfma_f32_32x32x16_bf16(kf[1],qr[0],negm,0,0,0), P0[6],P0[7],P0[8],P0[9],     pw0[2]=PKW(P0,4), pw0[3]=PKW(P0,6), pw0); \
    VRD(1); SBAR(); GAPA(C0=__builtin_amdgcn_mfma_f32_32x32x16_bf16(kf[2],qr[1],C0,0,0,0),   P0[10],P0[11],P0[12],P0[13], pw1[0]=PKW(P0,8), pw1[1]=PKW(P0,10), pw1); \
    VRD(5); SBAR(); GAPA(C1=__builtin_amdgcn_mfma_f32_32x32x16_bf16(kf[3],qr[1],C1,0,0,0),   P0[14],P0[15],P1[0],P1[1],   pw1[2]=PKW(P0,12),pw1[3]=PKW(P0,14), pw1); \
    VRD(2); SBAR(); GAPA(C0=__builtin_amdgcn_mfma_f32_32x32x16_bf16(kf[4],qr[2],C0,0,0,0),   P1[2],P1[3],P1[4],P1[5],     pw2[0]=PKW(P1,0), pw2[1]=PKW(P1,2), pw2); \
    VRD(6); SBAR(); GAPA(C1=__builtin_amdgcn_mfma_f32_32x32x16_bf16(kf[5],qr[2],C1,0,0,0),   P1[6],P1[7],P1[8],P1[9],     pw2[2]=PKW(P1,4), pw2[3]=PKW(P1,6), pw2); \
    VRD(3); SBAR(); GAPA(C0=__builtin_amdgcn_mfma_f32_32x32x16_bf16(kf[6],qr[3],C0,0,0,0),   P1[10],P1[11],P1[12],P1[13], pw3[0]=PKW(P1,8), pw3[1]=PKW(P1,10), pw3); \
    VRD(7); SBAR(); GAPA(C1=__builtin_amdgcn_mfma_f32_32x32x16_bf16(kf[7],qr[3],C1,0,0,0),   P1[14],P1[15],0.f,0.f,       pw3[2]=PKW(P1,12),pw3[3]=PKW(P1,14), pw3); \
    l_reg+=sacc; \
    if(GK){DMA_K((t)+3,sl_cur);} if(GV){DMA_V((t)+1,sl_next);} \
    CMASK(C0,C1,t); \
    { float a=MX3(C0[0],C0[1],C1[0]),b=MX3(C0[2],C0[3],C1[1]); a=MX3(a,C1[2],C1[3]); \
      _Pragma("unroll") for(int r=4;r<16;r+=4){a=MX3(a,C0[r],C0[r+1]);b=MX3(b,C0[r+2],C0[r+3]);a=MX3(a,C1[r],C1[r+1]);b=MX3(b,C1[r+2],C1[r+3]);} \
      float rm=__builtin_fmaxf(a,b); { auto rr=__builtin_amdgcn_permlane32_swap(__float_as_uint(rm),__float_as_uint(rm),false,false); rm=__builtin_fmaxf(__uint_as_float(rr[0]),__uint_as_float(rr[1])); } \
      resc=false; \
      if(__builtin_expect(__any(rm>(float)THRL),0)){ const float dl=__builtin_fmaxf(rm,0.f); mhat+=dl; \
        _Pragma("unroll") for(int r=0;r<16;++r){C0[r]-=dl;C1[r]-=dl;} \
        _Pragma("unroll") for(int r=0;r<16;++r)negm[r]=-mhat; asm volatile("":"+v"(negm)); \
        const float f=__builtin_amdgcn_exp2f(-dl); l_reg*=f; if(hi==0)wsf[r32]=f; resc=true; } } \
    SBAR(); \
    GAPB(o[0]=__builtin_amdgcn_mfma_f32_32x32x16_bf16(PAF(0),VFR(0),o[0],0,0,0), C0,0); \
    GAPB(o[1]=__builtin_amdgcn_mfma_f32_32x32x16_bf16(PAF(0),VFR(4),o[1],0,0,0), C0,4); \
    KRD(GL,0); GAPB(o[0]=__builtin_amdgcn_mfma_f32_32x32x16_bf16(PAF(1),VFR(1),o[0],0,0,0), C0,8); \
    KRD(GL,1); GAPB(o[1]=__builtin_amdgcn_mfma_f32_32x32x16_bf16(PAF(1),VFR(5),o[1],0,0,0), C0,12); \
    KRD(GL,2); GAPB(o[0]=__builtin_amdgcn_mfma_f32_32x32x16_bf16(PAF(2),VFR(2),o[0],0,0,0), C1,0); \
    KRD(GL,3); GAPB(o[1]=__builtin_amdgcn_mfma_f32_32x32x16_bf16(PAF(2),VFR(6),o[1],0,0,0), C1,4); \
    GAPB(o[0]=__builtin_amdgcn_mfma_f32_32x32x16_bf16(PAF(3),VFR(3),o[0],0,0,0), C1,8); \
    GAPB(o[1]=__builtin_amdgcn_mfma_f32_32x32x16_bf16(PAF(3),VFR(7),o[1],0,0,0), C1,12); \
    }while(0)
  int t=1;
  #undef CMASK
  #define CMASK(P0,P1,t) do{}while(0)
  for(;t+5<NT;t+=2){
    STEP(pB0,pB1,pA0,pA1,t,true,true,true);     WAIT_BAR(2); RESC(); ROT();
    STEP(pA0,pA1,pB0,pB1,t+1,true,true,true);   WAIT_BAR(2); RESC(); ROT();
  }
  #undef CMASK
  #define CMASK(P0,P1,t) do{}while(0)
  #define ENDW(tt) do{ if((tt)+3<NT){WAIT_BAR(2);} else if((tt)+2<NT){WAIT_BAR(1);} else {WAIT_BAR(0);} }while(0)
  for(;t+1<NT;t+=2){
    STEP(pB0,pB1,pA0,pA1,t,(t+3<NT),(t+1<NT),(t+1<NT));       ENDW(t);   RESC(); ROT();
    STEP(pA0,pA1,pB0,pB1,t+1,(t+4<NT),(t+2<NT),(t+2<NT));     ENDW(t+1); RESC(); ROT();
  }
  STEP(pB0,pB1,pA0,pA1,NT-1,false,false,false); RESC();
  { float sacc=pB0[0]+pB0[1]; _Pragma("unroll") for(int r=2;r<16;++r)sacc+=pB0[r]; _Pragma("unroll") for(int r=0;r<16;++r)sacc+=pB1[r]; l_reg+=sacc;
    pw0=(u32x4){PKW(pB0,0),PKW(pB0,2),PKW(pB0,4),PKW(pB0,6)};pw1=(u32x4){PKW(pB0,8),PKW(pB0,10),PKW(pB0,12),PKW(pB0,14)};pw2=(u32x4){PKW(pB1,0),PKW(pB1,2),PKW(pB1,4),PKW(pB1,6)};pw3=(u32x4){PKW(pB1,8),PKW(pB1,10),PKW(pB1,12),PKW(pB1,14)};
    SBAR(); pv(o,vb0+sl_cur,PAF(0),PAF(1),PAF(2),PAF(3)); }
  #undef PKW
  #undef PAF
  #undef VFR
  #undef PIN
  #undef MX3
  #undef GAPA
  #undef GAPB
  #undef EX
  #undef VRD
  #undef KRD
  #undef STEP
  #undef ENDW
  {auto rr=__builtin_amdgcn_permlane32_swap(__float_as_uint(l_reg),__float_as_uint(l_reg),false,false);l_reg=__uint_as_float(rr[0])+__uint_as_float(rr[1]);}
  if(hi==0)wsf[32+r32]=l_reg;asm volatile("s_waitcnt lgkmcnt(0)":::"memory");
  float rli[16];
  #pragma unroll
  for(int r=0;r<16;++r)rli[r]=__builtin_amdgcn_rcpf(wsf[32+crow(r,hi)]);
  bf16*Ow=O+(rowbase+q0+wid*QBLK)*OP+h*D;
  { bf16*stg=(bf16*)(shm+LDS_OST)+wid*2048;
    #pragma unroll
    for(int r=0;r<16;++r){const int orow=crow(r,hi);
      #pragma unroll
      for(int d0=0;d0<2;++d0)stg[orow*64+d0*32+r32]=__float2bfloat16(o[d0][r]*rli[r]);}
    asm volatile("s_waitcnt lgkmcnt(0)":::"memory");
    #pragma unroll
    for(int i=0;i<4;++i){const int row=i*8+(lane>>3),ch=lane&7; const u32x4 v=*(const u32x4*)(stg+row*64+ch*8); ATTN_STORE16(Ow+(long)row*OP+ch*8,v);} }
  asm volatile("s_waitcnt lgkmcnt(0)\n\ts_barrier":::"memory");
  #undef DMA_K
  #undef DMA_V
  #undef CMASK
  #undef START
  #undef RESC
  #undef ROT
}
constexpr int ATTN_LDS_BYTES=LDS_BYTES;
struct AttnTensors { const bf16* Q; const bf16* K; const bf16* V; bf16* O; };
struct AttnUnit { int bh; int qb; };
struct StaticOrder {
  int vcu, G;
  __device__ __forceinline__ explicit StaticOrder(int grid,int block):vcu((grid%8==0)?(block%8)*(grid/8)+block/8:block),G(grid){}
  __device__ __forceinline__ bool next(int i,AttnUnit&u)const{ const int per=(BATCH*NHEAD*NQB+G-1)/G; if(i>=per)return false; const int U=vcu*per+i; if(U>=BATCH*NHEAD*NQB)return false; u.bh=U/NQB; u.qb=U%NQB; return true; }
};
struct QueueOrder {
  unsigned* ctr; volatile __attribute__((address_space(3))) unsigned* slot;
  __device__ __forceinline__ bool next(int,AttnUnit&u)const{
    if(threadIdx.x==0)*slot=__hip_atomic_fetch_add(ctr,1u,__ATOMIC_RELAXED,__HIP_MEMORY_SCOPE_AGENT);
    __syncthreads(); const unsigned U=*slot; if(U>=(unsigned)(BATCH*NHEAD*NQB))return false; u.bh=(int)(U/NQB); u.qb=(int)(U%NQB); return true; }
};
template<class Sched,int THRL=8> __device__ __forceinline__ void attn_phase(char*lds,const AttnTensors&T,const Sched&S){
  AttnUnit u;
  for(int i=0;S.next(i,u);++i){ attn_unit<THRL>(u.bh/NHEAD,u.bh%NHEAD,u.qb,T.Q,T.K,T.V,T.O,lds); }
}
#undef SBAR
#undef WAIT_BAR
}
#define GAS __attribute__((address_space(1)))
#define LAS __attribute__((address_space(3)))
typedef unsigned short bf16;
typedef unsigned v4u __attribute__((ext_vector_type(4)));
typedef float f32x4 __attribute__((ext_vector_type(4)));
typedef short bf16x8 __attribute__((ext_vector_type(8)));
typedef GAS unsigned gu32;
typedef GAS unsigned long long gu64;
#define RLX_AGENT __ATOMIC_RELAXED, __HIP_MEMORY_SCOPE_AGENT
#define LDS_WAIT() asm volatile("s_waitcnt lgkmcnt(0)" ::: "memory")
#define VM_WAIT() asm volatile("s_waitcnt vmcnt(0)" ::: "memory")
__device__ __forceinline__ unsigned long long rt() { return __builtin_amdgcn_s_memrealtime(); }
__device__ __forceinline__ unsigned f2bf(float f) { unsigned u = __builtin_bit_cast(unsigned, f); return (u + 0x7fffu + ((u >> 16) & 1u)) >> 16; }
__device__ __forceinline__ unsigned pk2(float lo, float hi) { return f2bf(lo) | (f2bf(hi) << 16); }

#define XB_TMO      128
#define XB_XCNT(j)  (256  + 64 * (j))
#define XB_XSUB(j)  (1280 + 64 * (j))
#define XB_XGEN(j)  (2304 + 64 * (j))
#define XB_TOP      3328
#define XB_TOPGEN   3392
#define XCD_BAR_WORDS 3456
#ifndef XB_SPIN_CAP
#define XB_SPIN_CAP (1u << 26)
#endif

__device__ __forceinline__ unsigned xb_ld(unsigned* p)              { return __hip_atomic_load(p, __ATOMIC_RELAXED, __HIP_MEMORY_SCOPE_AGENT); }
__device__ __forceinline__ unsigned xb_add(unsigned* p, unsigned v) { return __hip_atomic_fetch_add(p, v, __ATOMIC_RELAXED, __HIP_MEMORY_SCOPE_AGENT); }
__device__ __forceinline__ unsigned xb_xcc_id() { return (unsigned)__builtin_amdgcn_s_getreg((3 << 11) | 20) & 0xFu; }
#define XB_SPIN(cond, bar) do { unsigned _sp = 0; while (cond) { __builtin_amdgcn_s_sleep(1); \
    if ((++_sp & 255u) == 0u) { if (xb_ld(&(bar)[XB_TMO])) break; if (_sp > XB_SPIN_CAP) { atomicAdd(&(bar)[XB_TMO], 1u); break; } } } } while (0)

struct XcdBarrier {
    unsigned* bar; unsigned x;
    volatile LAS unsigned* st;
};

__device__ __forceinline__ XcdBarrier xcd_barrier_post(unsigned* bar, volatile LAS unsigned* st) {
    XcdBarrier b; b.bar = bar; b.x = xb_xcc_id(); b.st = st;
    if (threadIdx.x == 0) (void)xb_add(&bar[XB_XCNT(b.x)], 1u);
    return b;
}
__device__ __forceinline__ void xcd_barrier_complete(unsigned* bar, unsigned x, unsigned& nloc, unsigned& nx) {
    const unsigned G = gridDim.x * gridDim.y * gridDim.z;
    unsigned sum, cnt, mine, sp = 0u;
    for (;;) {
        sum = 0u; cnt = 0u; mine = 0u;
#pragma unroll
        for (unsigned j = 0; j < 16; ++j) { const unsigned c = xb_ld(&bar[XB_XCNT(j)]); sum += c; cnt += (c > 0u) ? 1u : 0u; mine = (j == x) ? c : mine; }
        if (sum == G) break;
        __builtin_amdgcn_s_sleep(1);
        if ((++sp & 255u) == 0u) { if (xb_ld(&bar[XB_TMO])) break; if (sp > XB_SPIN_CAP) { atomicAdd(&bar[XB_TMO], 1u); break; } }
    }
    nloc = mine > 0u ? mine : 1u; nx = cnt > 0u ? cnt : 1u;
}

__device__ __forceinline__ void xcd_barrier(const XcdBarrier& b) {
    asm volatile("s_waitcnt vmcnt(0)" ::: "memory");
    __syncthreads();
    if (threadIdx.x == 0) {
        unsigned* bar = b.bar;
        __builtin_amdgcn_s_waitcnt(0);
        unsigned nloc = b.st[0], nx = b.st[1];
        if (nloc == 0u) { xcd_barrier_complete(bar, b.x, nloc, nx); b.st[0] = nloc; b.st[1] = nx; }
        const unsigned old = xb_add(&bar[XB_XSUB(b.x)], 1u);
        const unsigned gen = old / nloc;
        if (old + 1u == (gen + 1u) * nloc) {
            __builtin_amdgcn_fence(__ATOMIC_RELEASE, "agent");
            asm volatile("s_waitcnt vmcnt(0)" ::: "memory");
            const unsigned og = xb_add(&bar[XB_TOP], 1u);
            const unsigned tg = og / nx;
            if (og + 1u == (tg + 1u) * nx) xb_add(&bar[XB_TOPGEN], 1u);
            else XB_SPIN(xb_ld(&bar[XB_TOPGEN]) == tg, bar);
            __builtin_amdgcn_fence(__ATOMIC_ACQUIRE, "agent");
            xb_add(&bar[XB_XGEN(b.x)], 1u);
            asm volatile("s_waitcnt vmcnt(0)" ::: "memory");
        } else {
            XB_SPIN(xb_ld(&bar[XB_XGEN(b.x)]) == gen, bar);
            __builtin_amdgcn_fence(__ATOMIC_ACQUIRE, "agent");
            asm volatile("s_waitcnt vmcnt(0)" ::: "memory");
        }
    }
    __syncthreads();
}
struct Args { const float* in[18]; float* out; unsigned char* ws; int ph_lo, ph_hi; };
enum { I_X = 0, I_C, I_WADA, I_BADA, I_NMG, I_WIN, I_QG, I_KG, I_CONVW, I_CONVB, I_GATEB, I_MNG, I_WOUT, I_NFG, I_WGATE, I_WUP, I_WDOWN, I_FNG };

__device__ __forceinline__ float wave_sum(float v) {
#pragma unroll
    for (int o = 1; o < 64; o <<= 1) v += __shfl_xor(v, o);
    return v;
}
__device__ __forceinline__ float bf2f(bf16 h) { return __builtin_bit_cast(float, (unsigned)h << 16); }
__device__ __forceinline__ float bflo(unsigned w) { return __builtin_bit_cast(float, w << 16); }
__device__ __forceinline__ float bfhi(unsigned w) { return __builtin_bit_cast(float, w & 0xffff0000u); }

__device__ __forceinline__ int colmap_in(int j) {
    const int pn = j >> 8, jj = j & 255, bj = jj >> 7, wc = (jj >> 5) & 3, n = (jj >> 4) & 1, fq = (jj >> 2) & 3, e = jj & 3;
    return (pn <= 2) ? 256 * pn + 64 * wc + 16 * (2 * bj + n) + 4 * fq + e : 256 * pn + 128 * bj + 32 * wc + 8 * fq + 4 * n + e;
}
__device__ __forceinline__ int colmap_gu(int j) {
    const int pn = j >> 8, jj = j & 255, wc = (jj >> 5) & 3, n = (jj >> 4) & 1, fq = (jj >> 2) & 3, e = jj & 3;
    return 128 * pn + 32 * wc + 8 * fq + 4 * n + e;
}
__device__ __forceinline__ void transpose_item(const float* W, int ldw, int K, bf16* WT, int n0, int k0, int srccol, LAS float* scr, int lane) {
#pragma unroll 8
    for (int i = 0; i < 32; ++i) { const int kk = 2 * i + (lane >> 5); scr[kk * 33 + (lane & 31)] = W[(size_t)(k0 + kk) * ldw + srccol]; }
    LDS_WAIT(); asm volatile("" ::: "memory");
    const int c = lane & 7;
#pragma unroll
    for (int j = 0; j < 4; ++j) { const int n = (lane >> 3) + 8 * j; const LAS float* s = scr + (8 * c) * 33 + n;
        v4u o; o.x = pk2(s[0 * 33], s[1 * 33]); o.y = pk2(s[2 * 33], s[3 * 33]); o.z = pk2(s[4 * 33], s[5 * 33]); o.w = pk2(s[6 * 33], s[7 * 33]);
        *(GAS v4u*)(WT + (size_t)(n0 + n) * K + k0 + 8 * c) = o; }
    LDS_WAIT(); asm volatile("" ::: "memory");
}

__device__ __forceinline__ void p0_prologue(const Args& A, LAS unsigned char* lds, int tid, int lane, int wave, int vcu, int G) {
    unsigned char* ws = A.ws;
    LAS float* sc = (LAS float*)(lds + 73728);
    for (int i = tid; i < 8192; i += NTHREADS) { const int b = i >> 10, k = i & 1023; const float cv = A.in[I_C][i]; sc[k * 8 + b] = cv / (1.0f + expf(-cv)); }
    __syncthreads();
    LAS float* scr = (LAS float*)(lds + wave * 9216);
    const int gw = vcu * NWAVES + wave, NGW = G * NWAVES;
    constexpr int I_MOD = 96 * 8, T_IN = 16 * 88, T_OUT = 16 * 32, T_GU = 16 * 176, T_DN = 44 * 32;
    constexpr int NITEMS = I_MOD + T_IN + T_OUT + T_GU + T_DN;
    float* mod = (float*)(ws + WS_MOD);
    for (int it = gw; it < NITEMS; it += NGW) {
        int r = it;
        if (r < I_MOD) {
            const int cg = r >> 3, ks = r & 7, col = cg * 64 + lane; const float* w = A.in[I_WADA] + (size_t)(ks * 128) * NMOD + col;
            float acc[8];
#pragma unroll
            for (int b = 0; b < 8; ++b) acc[b] = 0.f;
#pragma unroll 8
            for (int kk = 0; kk < 128; ++kk) { const float wv = w[(size_t)kk * NMOD]; const f32x4 s0 = *(const LAS f32x4*)(sc + (ks * 128 + kk) * 8), s1 = *(const LAS f32x4*)(sc + (ks * 128 + kk) * 8 + 4);
                acc[0] += s0[0] * wv; acc[1] += s0[1] * wv; acc[2] += s0[2] * wv; acc[3] += s0[3] * wv; acc[4] += s1[0] * wv; acc[5] += s1[1] * wv; acc[6] += s1[2] * wv; acc[7] += s1[3] * wv; }
            const float bias = (ks == 0) ? A.in[I_BADA][col] : 0.f;
#pragma unroll
            for (int b = 0; b < 8; ++b) atomicAdd(mod + b * NMOD + col, acc[b] + bias);
            continue;
        }
        r -= I_MOD;
        if (r < T_IN) { const int kb = r / 88, nb = r % 88; transpose_item(A.in[I_WIN], NIN, DMODEL, (bf16*)(ws + WS_WIN), 32 * nb, 64 * kb, colmap_in(32 * nb + (lane & 31)), scr, lane); continue; }
        r -= T_IN;
        if (r < T_OUT) { const int kb = r / 32, nb = r % 32; transpose_item(A.in[I_WOUT], DMODEL, DMODEL, (bf16*)(ws + WS_WO), 32 * nb, 64 * kb, 32 * nb + (lane & 31), scr, lane); continue; }
        r -= T_OUT;
        if (r < T_GU) { const int kb = r / 176, nb = r % 176; const int j0 = 32 * nb; const float* W = ((j0 >> 7) & 1) ? A.in[I_WUP] : A.in[I_WGATE];
            transpose_item(W, FFH, DMODEL, (bf16*)(ws + WS_WGU), j0, 64 * kb, colmap_gu(j0 + (lane & 31)), scr, lane); continue; }
        r -= T_GU;
        { const int kb = r / 32, nb = r % 32; transpose_item(A.in[I_WDOWN], DMODEL, FFH, (bf16*)(ws + WS_WD), 32 * nb, 64 * kb, 32 * nb + (lane & 31), scr, lane); }
    }
    if (blockIdx.x == 0) {
        for (int i = tid; i < 1024; i += NTHREADS) { const int pos = i >> 4, f = i & 15; const float inv = powf(10000.0f, -(float)(2 * f) / 32.0f); const float ang = (float)pos * inv;
            ((float*)(ws + WS_TABC))[i] = cosf(ang); ((float*)(ws + WS_TABS))[i] = sinf(ang); }
        if (tid < 128) ((float*)(ws + WS_QKG))[tid] = (tid < 64) ? A.in[I_QG][tid] : A.in[I_KG][tid - 64];
    }
    if (blockIdx.x == 1 % G) {
        for (int i = tid; i < 16 * 1024; i += NTHREADS) { const int gi = i >> 10, k = i & 1023; ((bf16*)(ws + WS_WGT))[i] = (bf16)f2bf(A.in[I_WIN][(size_t)k * NIN + NPROJ + gi]); }
    }
}

template <int MODE> __device__ __forceinline__ void row_pass(const Args& A, int lane, int gw, int NGW) {
    const float* src = (MODE == 0) ? A.in[I_X] : A.out; const float* g = (MODE == 0) ? A.in[I_NMG] : (MODE == 1) ? A.in[I_NFG] : A.in[I_FNG];
    const float* mod = (const float*)(A.ws + WS_MOD); bf16* XN = (bf16*)(A.ws + WS_XN);
    for (int rg = gw; rg < M / 16; rg += NGW) {
        const int b = (rg * 16) >> 12; f32x4 gp[4], sh[4];
#pragma unroll
        for (int j = 0; j < 4; ++j) { const int col = 4 * lane + 256 * j; gp[j] = *(const f32x4*)(g + col);
            if (MODE < 2) { const int o = (MODE == 0) ? 0 : 3072; const f32x4 s = *(const f32x4*)(mod + b * NMOD + o + 1024 + col); gp[j] = gp[j] * (s + 1.0f); sh[j] = *(const f32x4*)(mod + b * NMOD + o + col); } }
        for (int i = 0; i < 16; ++i) {
            const size_t row = (size_t)rg * 16 + i; const f32x4* xr = (const f32x4*)(src + row * DMODEL) + lane;
            f32x4 v[4]; float s = 0.f;
#pragma unroll
            for (int j = 0; j < 4; ++j) { v[j] = xr[64 * j]; s += (v[j][0] * v[j][0] + v[j][1] * v[j][1]) + (v[j][2] * v[j][2] + v[j][3] * v[j][3]); }
            const float rstd = 1.0f / sqrtf(wave_sum(s) * (1.0f / DMODEL) + EPS);
            if (MODE < 2) {
                unsigned long long* o8 = (unsigned long long*)(XN + row * DMODEL) + lane;
#pragma unroll
                for (int j = 0; j < 4; ++j) { const f32x4 y = v[j] * rstd * gp[j] + sh[j]; o8[64 * j] = (unsigned long long)pk2(y[0], y[1]) | ((unsigned long long)pk2(y[2], y[3]) << 32); }
            } else {
                f32x4* o = (f32x4*)(A.out + row * DMODEL) + lane;
#pragma unroll
                for (int j = 0; j < 4; ++j) o[64 * j] = v[j] * rstd * gp[j];
            }
        }
    }
}
__device__ __forceinline__ void gates_pass(const Args& A, int lane, int gw, int NGW) {
    const bf16* XN = (const bf16*)(A.ws + WS_XN); const bf16* WgT = (const bf16*)(A.ws + WS_WGT); float* GT = (float*)(A.ws + WS_GATES);
    const int fr = lane & 15, fq = lane >> 4; const f32x4 gb = *(const f32x4*)(A.in[I_GATEB] + 4 * fq);
    for (int rg = gw; rg < M / 16; rg += NGW) {
        f32x4 acc = {0.f, 0.f, 0.f, 0.f}; const bf16* ap = XN + ((size_t)rg * 16 + fr) * DMODEL + 8 * fq; const bf16* bp = WgT + (size_t)fr * DMODEL + 8 * fq;
#pragma unroll 4
        for (int k0 = 0; k0 < DMODEL; k0 += 32) acc = __builtin_amdgcn_mfma_f32_16x16x32_bf16(*(const bf16x8*)(bp + k0), *(const bf16x8*)(ap + k0), acc, 0, 0, 0);
        *(f32x4*)(GT + ((size_t)rg * 16 + fr) * 16 + 4 * fq) = acc + gb;
    }
}
namespace ml {
typedef float f32x16 __attribute__((ext_vector_type(16)));
typedef short s16x4 __attribute__((ext_vector_type(4)));
typedef short v4i16_t __attribute__((ext_vector_type(4)));
#define ML_MFMA(a, b, c) __builtin_amdgcn_mfma_f32_32x32x16_bf16((a), (b), (c), 0, 0, 0)
__device__ __forceinline__ int crow(int r, int hi) { return (r & 3) + 8 * (r >> 2) + 4 * hi; }
__device__ __forceinline__ unsigned off_b(unsigned row, unsigned ch) { return 256u * row + 16u * (ch ^ (((row & 3) << 2) | ((row >> 2) & 3))); }
__device__ __forceinline__ unsigned cvtpk(float lo, float hi) { typedef float f2 __attribute__((ext_vector_type(2))); typedef __bf16 b2 __attribute__((ext_vector_type(2))); f2 v = {lo, hi}; b2 r = __builtin_convertvector(v, b2); return __builtin_bit_cast(unsigned, r); }
__device__ __forceinline__ bf16x8 pack8(const f32x16& x, int s) { v4u p; p.x = cvtpk(x[8 * s], x[8 * s + 1]); p.y = cvtpk(x[8 * s + 2], x[8 * s + 3]); p.z = cvtpk(x[8 * s + 4], x[8 * s + 5]); p.w = cvtpk(x[8 * s + 6], x[8 * s + 7]); return __builtin_bit_cast(bf16x8, p); }
constexpr float KSCALE = 0.08838834764831845f;
__device__ __forceinline__ void prep_pass(const Args& A, LAS unsigned char* lds, int tid, int bx, int G) {
    const bf16* QKM = (const bf16*)(A.ws + WS_QKM); const bf16* VM = (const bf16*)(A.ws + WS_VM);
    bf16* QC = (bf16*)(A.ws + WS_QC); bf16* KC = (bf16*)(A.ws + WS_KC); bf16* VF = (bf16*)(A.ws + WS_VF);
    if (bx < 8) {
        const int lane = tid & 63, ci = bx * 8 + (tid >> 6), b = ci >> 3, h = (ci >> 1) & 3, dir = ci & 1; const float* GT = (const float*)(A.ws + WS_GATES); float* SCN = (float*)(A.ws + WS_SCN) + (size_t)ci * 64 * 256;
        const int sn = dir ? 63 - lane : lane; float m_carry = 0.f;
        const float* gp = GT + ((size_t)b * SEQ + 64 * (dir ? 63 : 0) + sn) * 16 + dir * 8 + h; float gi = gp[0], gfr = gp[4];
        for (int j = 0; j < 64; ++j) { const int cn = dir ? 63 - j : j; float gi_n = 0.f, gf_n = 0.f;
            if (j + 1 < 64) { const float* gq = GT + ((size_t)b * SEQ + 64 * (dir ? 62 - j : j + 1) + sn) * 16 + dir * 8 + h; gi_n = gq[0]; gf_n = gq[4]; }
            float bc = fminf(gfr, 0.f) - log1pf(__expf(-fabsf(gfr)));
#pragma unroll
            for (int o = 1; o < 64; o <<= 1) { const float t = __shfl_up(bc, o); if (lane >= o) bc += t; }
            const float u = gi - bc; float pm = u;
#pragma unroll
            for (int o = 1; o < 64; o <<= 1) { const float t = __shfl_up(pm, o); if (lane >= o) pm = fmaxf(pm, t); }
            const float Mt = fmaxf(m_carry, pm), Ml = __shfl(Mt, 63), gt = __shfl(bc, 63); float* rec = SCN + (size_t)cn * 256;
            rec[sn] = __expf(Ml - Mt); rec[64 + sn] = __expf(m_carry - Mt); rec[128 + sn] = __expf(u - Ml); rec[192 + sn] = __expf(-(bc + Mt));
            m_carry = gt + Ml; gi = gi_n; gfr = gf_n; }
    }
    volatile LAS unsigned* qslot = (volatile LAS unsigned*)(lds + MISC_OFF + 80);
    for (;;) {
        if (tid == 0) *qslot = __hip_atomic_fetch_add((unsigned*)(A.ws + WS_CTL) + CW_QUEUE + 128, 1u, __ATOMIC_RELAXED, __HIP_MEMORY_SCOPE_AGENT);
        __syncthreads(); const int it = (int)*qslot; __syncthreads();
        if (it >= 512 + 2048) break;
        if (it < 512) {
            const int b = it >> 6, c = it & 63, ch = 2 * tid; const float* cw = A.in[I_CONVW]; const float* cb = A.in[I_CONVB];
            float w0[5], w1[5];
#pragma unroll
            for (int j = 0; j < 5; ++j) { w0[j] = cw[j * 1024 + ch]; w1[j] = cw[j * 1024 + ch + 1]; }
            const float b0 = cb[ch], b1 = cb[ch + 1]; const float osc = (ch >= 512) ? KSCALE : 1.0f;
            unsigned xr[68];
#pragma unroll
            for (int i = 0; i < 68; ++i) { const int p = 64 * c - 2 + i; xr[i] = (p >= 0 && p < SEQ) ? *(const unsigned*)(QKM + ((size_t)b * SEQ + p) * 1024 + ch) : 0u; }
            bf16* dst = (ch < 512) ? QC + ch : KC + (ch - 512);
#pragma unroll
            for (int i = 0; i < 64; ++i) { float y0 = b0, y1 = b1;
#pragma unroll
                for (int j = 0; j < 5; ++j) { y0 += w0[j] * bflo(xr[i + j]); y1 += w1[j] * bfhi(xr[i + j]); }
                y0 = y0 / (1.0f + __expf(-y0)) * osc; y1 = y1 / (1.0f + __expf(-y1)) * osc;
                *(unsigned*)(dst + ((size_t)b * SEQ + 64 * c + i) * 512) = pk2(y0, y1); }
        } else {
            const int r = it - 512, b = r >> 8, c = (r >> 2) & 63, h = r & 3;
#pragma unroll
            for (int i = 0; i < 2; ++i) { const int idx = tid + NTHREADS * i, row = idx >> 4, ch = idx & 15; *(LAS v4u*)(lds + row * 256 + ch * 16) = *(const v4u*)(VM + ((size_t)b * SEQ + 64 * c + row) * 512 + h * 128 + ch * 8); }
            __syncthreads();
            bf16* blk = VF + (size_t)((b * 4 + h) * 64 + c) * 8192;
#pragma unroll
            for (int i = 0; i < 2; ++i) { const int o = tid + NTHREADS * i, ln = o & 63, ks = (o >> 6) & 3, vb = o >> 8, j = ln & 31, hi = ln >> 5; unsigned e[8];
#pragma unroll
                for (int jj = 0; jj < 8; ++jj) { const int s = 16 * ks + 8 * (jj >> 2) + 4 * hi + (jj & 3); e[jj] = *(const LAS unsigned short*)(lds + s * 256 + (32 * vb + j) * 2); }
                v4u w; w.x = e[0] | (e[1] << 16); w.y = e[2] | (e[3] << 16); w.z = e[4] | (e[5] << 16); w.w = e[6] | (e[7] << 16);
                *(v4u*)(blk + (size_t)o * 8) = w; }
            __syncthreads();
        }
    }
}

constexpr int ML_XCH = 131072, ML_VEC = 143360;
constexpr int V_SCAN = 0  , V_DENX = 1280  , V_DQ = 1376  , V_RD = 1632  , V_NVS = 1888  , V_NP = 2016  , V_END = 2528;
static_assert(ML_VEC + V_END * 4 <= LDSCTL_OFF, "mLSTM LDS map");

__device__ __forceinline__ void mlstm_item(const Args& A, int item, LAS unsigned char* L, int tid) {
    const int b = item >> 3, h = (item >> 1) & 3, dir = item & 1;
    const int lane = tid & 63, wave = __builtin_amdgcn_readfirstlane(tid >> 6), w = wave & 3;
    const bf16* QC = (const bf16*)(A.ws + WS_QC); const bf16* KC = (const bf16*)(A.ws + WS_KC); const bf16* VF = (const bf16*)(A.ws + WS_VF);
    float* HF = (float*)(A.ws + WS_HF) + (size_t)dir * M * 512; const float* SCN = (const float*)(A.ws + WS_SCN) + (size_t)((b * 4 + h) * 2 + dir) * 64 * 256;
    LAS float* VEC = (LAS float*)(L + ML_VEC);
    LAS unsigned char* XCH = L + ML_XCH;
    const size_t rowbase = (size_t)b * SEQ;
#define ML_CHUNK(j) (dir ? 63 - (j) : (j))
#define ML_BAR() asm volatile("s_waitcnt lgkmcnt(0)\n\ts_barrier" ::: "memory")
#define ML_FRESH() int ln = lane; asm volatile("" : "+v"(ln)); const int r32 = ln & 31, hh = ln >> 5; (void)r32; (void)hh
    if (wave >= 4) {
        const unsigned lbase = (unsigned)(uintptr_t)L;
#define ML_GLDS16(src, ldsoff) do { unsigned keep_; asm volatile("s_mov_b32 %0, m0\n\ts_mov_b32 m0, %2\n\ts_nop 0\n\tglobal_load_lds_dwordx4 %1, off\n\ts_mov_b32 m0, %0" : "=&s"(keep_) : "v"(src), "s"((unsigned)__builtin_amdgcn_readfirstlane((int)(lbase + (ldsoff)))) : "memory"); } while (0)
#define ML_GLDS4(src, ldsoff) do { unsigned keep_; asm volatile("s_mov_b32 %0, m0\n\ts_mov_b32 m0, %2\n\ts_nop 0\n\tglobal_load_lds_dword %1, off\n\ts_mov_b32 m0, %0" : "=&s"(keep_) : "v"(src), "s"((unsigned)__builtin_amdgcn_readfirstlane((int)(lbase + (ldsoff)))) : "memory"); } while (0)
#define ML_DMA(cn, sl, LN) do { _Pragma("unroll") for (int i_ = 0; i_ < 4; ++i_) { const int p_ = w * 4 + i_, row_ = 4 * p_ + ((LN) >> 4), ch_ = ((LN) & 15) ^ (((row_ & 3) << 2) | ((row_ >> 2) & 3)); \
        const size_t so_ = (rowbase + 64 * (cn) + row_) * 512 + h * 128 + ch_ * 8; \
        ML_GLDS16(QC + so_, (sl) * 32768 + p_ * 1024); ML_GLDS16(KC + so_, (sl) * 32768 + 16384 + p_ * 1024); } \
        ML_GLDS4(SCN + (size_t)(cn) * 256 + w * 64 + (LN), ML_VEC + (V_SCAN + (sl) * 320 + w * 64) * 4); } while (0)
        float decay_prev = 0.f, nv = 0.f;
        if (lane < 32) { VEC[V_NP + 0 * 128 + 32 * w + lane] = 0.f; VEC[V_NP + 1 * 128 + 32 * w + lane] = 0.f; VEC[V_NP + 2 * 128 + 32 * w + lane] = 0.f; VEC[V_NP + 3 * 128 + 32 * w + lane] = 0.f; }
        ML_DMA(ML_CHUNK(0), 0, lane); ML_DMA(ML_CHUNK(1), 1, lane); ML_DMA(ML_CHUNK(2), 2, lane);
        asm volatile("s_waitcnt vmcnt(18)" ::: "memory");
        ML_BAR();
        for (int j = 0; j < 64; ++j) {
            const int sl = j & 3;
            const LAS unsigned char* Qb = L + sl * 32768; const LAS unsigned char* Kb = Qb + 16384; const LAS float* SC = VEC + V_SCAN + sl * 320;
            if (j + 3 < 64) { ML_FRESH(); ML_DMA(ML_CHUNK(j + 3), (j + 3) & 3, ln); }
            const float decay = SC[64 + (dir ? 0 : 63)];
            { ML_FRESH(); if (ln < 32) { nv = decay_prev * nv + ((VEC[V_NP + 32 * w + ln] + VEC[V_NP + 128 + 32 * w + ln]) + (VEC[V_NP + 256 + 32 * w + ln] + VEC[V_NP + 384 + 32 * w + ln])); VEC[V_NVS + 32 * w + ln] = nv; } }
            decay_prev = decay;
            { ML_FRESH(); float dq = 0.f;
#pragma unroll
              for (int c4 = 0; c4 < 4; ++c4) { const v4u qw = *(const LAS v4u*)(Qb + off_b(ln, 4 * w + c4)); const f32x4 n0 = *(const LAS f32x4*)(VEC + V_NVS + 32 * w + 8 * c4), n1 = *(const LAS f32x4*)(VEC + V_NVS + 32 * w + 8 * c4 + 4);
                  dq += bflo(qw.x) * n0[0] + bfhi(qw.x) * n0[1] + bflo(qw.y) * n0[2] + bfhi(qw.y) * n0[3] + bflo(qw.z) * n1[0] + bfhi(qw.z) * n1[1] + bflo(qw.w) * n1[2] + bfhi(qw.w) * n1[3]; }
              VEC[V_DQ + 64 * w + ln] = dq; }
            ML_BAR();
            { ML_FRESH(); float p0 = 0.f, p1 = 0.f;
#pragma unroll
              for (int i = 0; i < 16; ++i) { const int s = 16 * w + i; const unsigned kw = *(const LAS unsigned*)(Kb + off_b(s, ln >> 2) + (ln & 3) * 4); const float ws_ = SC[128 + s]; p0 += ws_ * bflo(kw); p1 += ws_ * bfhi(kw); }
              typedef float f32x2_t __attribute__((ext_vector_type(2))); *(LAS f32x2_t*)(VEC + V_NP + 128 * w + 2 * ln) = (f32x2_t){p0, p1}; }
            if (j + 3 < 64) asm volatile("s_waitcnt vmcnt(18)" ::: "memory"); else if (j + 2 < 64) asm volatile("s_waitcnt vmcnt(9)" ::: "memory"); else asm volatile("s_waitcnt vmcnt(0)" ::: "memory");
            ML_BAR();
        }
#undef ML_GLDS16
#undef ML_GLDS4
#undef ML_DMA
    } else {
        const int r32c = lane & 31; (void)r32c;
        const int sbt = (w == 2) ? 1 : ((w == 1) ? dir : 0), tbt = (w == 2) ? 1 : ((w == 1) ? (1 - dir) : 0);
        f32x16 CT[4];
#pragma unroll
        for (int i = 0; i < 4; ++i)
#pragma unroll
            for (int r = 0; r < 16; ++r) CT[i][r] = 0.f;
#define ML_VLOAD(dst, cn, LN) do { const bf16* vb_ = VF + (size_t)((b * 4 + h) * 64 + (cn)) * 8192 + (size_t)((w * 4) * 64 + (LN)) * 8; _Pragma("unroll") for (int k_ = 0; k_ < 4; ++k_) dst[k_] = *(const bf16x8*)(vb_ + k_ * 512); } while (0)
#define ML_SB() __builtin_amdgcn_sched_barrier(0)
        typedef unsigned u32x2_t __attribute__((ext_vector_type(2)));
        bf16x8 vf[4], vnext[4];
        ML_VLOAD(vnext, ML_CHUNK(0), lane);
        ML_BAR();
        for (int j = 0; j < 64; ++j) {
            const int cn = ML_CHUNK(j), sl = j & 3;
            const LAS unsigned char* Qb = L + sl * 32768; const LAS unsigned char* Kb = Qb + 16384; const LAS float* SC = VEC + V_SCAN + sl * 320;
            { ML_FRESH();
#pragma unroll
            for (int ks = 0; ks < 4; ++ks) { const f32x4 wa = *(const LAS f32x4*)(SC + 128 + 16 * ks + 4 * hh), wb = *(const LAS f32x4*)(SC + 128 + 16 * ks + 8 + 4 * hh); const v4u raw = __builtin_bit_cast(v4u, vnext[ks]); v4u o;
                o.x = cvtpk(bflo(raw.x) * wa[0], bfhi(raw.x) * wa[1]); o.y = cvtpk(bflo(raw.y) * wa[2], bfhi(raw.y) * wa[3]); o.z = cvtpk(bflo(raw.z) * wb[0], bfhi(raw.z) * wb[1]); o.w = cvtpk(bflo(raw.w) * wb[2], bfhi(raw.w) * wb[3]);
                vf[ks] = __builtin_bit_cast(bf16x8, o); } }
            if (j + 1 < 64) { ML_FRESH(); ML_VLOAD(vnext, ML_CHUNK(j + 1), ln); }
            const float decay = SC[64 + (dir ? 0 : 63)];
            if (w != 3) {
                ML_FRESH();
                f32x16 st;
#pragma unroll
                for (int r = 0; r < 16; ++r) st[r] = 0.f;
                const LAS unsigned char* kp = Kb + 256 * (32 * sbt + r32); const LAS unsigned char* qp = Qb + 256 * (32 * tbt + r32); const unsigned fx = (((unsigned)r32 & 3u) << 2) | (((unsigned)r32 >> 2) & 3u);
                bf16x8 ka[2], qb[2];
                ka[0] = *(const LAS bf16x8*)(kp + 16 * ((0 + hh) ^ fx)); qb[0] = *(const LAS bf16x8*)(qp + 16 * ((0 + hh) ^ fx));
#pragma unroll
                for (int ks = 0; ks < 8; ++ks) {
                    if (ks + 1 < 8) { ka[(ks + 1) & 1] = *(const LAS bf16x8*)(kp + 16 * ((2 * (ks + 1) + hh) ^ fx)); qb[(ks + 1) & 1] = *(const LAS bf16x8*)(qp + 16 * ((2 * (ks + 1) + hh) ^ fx)); }
                    st = ML_MFMA(ka[ks & 1], qb[ks & 1], st); ML_SB(); }
                const float et = SC[32 * tbt + r32]; float dx = 0.f;
#pragma unroll
                for (int g = 0; g < 4; ++g) { const f32x4 wv = *(const LAS f32x4*)(SC + 128 + 32 * sbt + 8 * g + 4 * hh);
#pragma unroll
                    for (int e = 0; e < 4; ++e) { const int r = 4 * g + e, sl_ = 8 * g + 4 * hh + e; const bool keep = (w == 1) || (dir ? (sl_ >= r32) : (sl_ <= r32)); const float mk = keep ? et : 0.f; const float x = st[r] * mk; st[r] = x; dx += x * wv[e]; } }
                dx += __shfl_xor(dx, 32);
                if (hh == 0) VEC[V_DENX + 32 * w + r32] = dx;
                *(LAS bf16x8*)(XCH + (w * 2 + 0) * 1024 + ln * 16) = pack8(st, 0); *(LAS bf16x8*)(XCH + (w * 2 + 1) * 1024 + ln * 16) = pack8(st, 1);
            }
            f32x16 acc0, acc1;
#pragma unroll
            for (int r = 0; r < 16; ++r) { acc0[r] = 0.f; acc1[r] = 0.f; }
            { ML_FRESH();
              const LAS unsigned char* q0p = Qb + 256 * r32 + 8 * hh; const LAS unsigned char* q1p = q0p + 256 * 32; const unsigned fx = (((unsigned)r32 & 3u) << 2) | (((unsigned)r32 >> 2) & 3u);
              u32x2_t qa[2][4];
#define ML_QLD(gi, buf) do { qa[buf][0] = *(const LAS u32x2_t*)(q0p + 16 * ((unsigned)(2 * (gi)) ^ fx)); qa[buf][1] = *(const LAS u32x2_t*)(q0p + 16 * ((unsigned)(2 * (gi) + 1) ^ fx)); \
                               qa[buf][2] = *(const LAS u32x2_t*)(q1p + 16 * ((unsigned)(2 * (gi)) ^ fx)); qa[buf][3] = *(const LAS u32x2_t*)(q1p + 16 * ((unsigned)(2 * (gi) + 1) ^ fx)); } while (0)
              ML_QLD(0, 0);
#pragma unroll
              for (int gi = 0; gi < 8; ++gi) {
                  if (gi + 1 < 8) ML_QLD(gi + 1, (gi + 1) & 1);
                  const bf16x8 cf = pack8(CT[gi >> 1], gi & 1);
                  const v4u q0 = {qa[gi & 1][0].x, qa[gi & 1][0].y, qa[gi & 1][1].x, qa[gi & 1][1].y}, q1 = {qa[gi & 1][2].x, qa[gi & 1][2].y, qa[gi & 1][3].x, qa[gi & 1][3].y};
                  acc0 = ML_MFMA(__builtin_bit_cast(bf16x8, q0), cf, acc0); acc1 = ML_MFMA(__builtin_bit_cast(bf16x8, q1), cf, acc1); ML_SB(); }
#undef ML_QLD
            }
            ML_BAR();
            { ML_FRESH(); const int tb = ln >> 5, tl = ln & 31; const float dxs = dir ? (tb ? VEC[V_DENX + 64 + tl] : VEC[V_DENX + tl] + VEC[V_DENX + 32 + tl]) : (tb ? VEC[V_DENX + 32 + tl] + VEC[V_DENX + 64 + tl] : VEC[V_DENX + tl]);
              const float dqs = (VEC[V_DQ + ln] + VEC[V_DQ + 64 + ln]) + (VEC[V_DQ + 128 + ln] + VEC[V_DQ + 192 + ln]);
              const float den = SC[64 + ln] * dqs + dxs; VEC[V_RD + 64 * w + ln] = 1.0f / fmaxf(fabsf(den), SC[192 + ln]); }
            { ML_FRESH();
              const bf16x8 x00 = *(const LAS bf16x8*)(XCH + 0 * 1024 + ln * 16), x01 = *(const LAS bf16x8*)(XCH + 1 * 1024 + ln * 16);
              const bf16x8 x10 = *(const LAS bf16x8*)(XCH + 2 * 1024 + ln * 16), x11 = *(const LAS bf16x8*)(XCH + 3 * 1024 + ln * 16);
              const bf16x8 x20 = *(const LAS bf16x8*)(XCH + 4 * 1024 + ln * 16), x21 = *(const LAS bf16x8*)(XCH + 5 * 1024 + ln * 16);
#pragma unroll
            for (int g = 0; g < 4; ++g) { const f32x4 w0 = *(const LAS f32x4*)(SC + 64 + 8 * g + 4 * hh), w1 = *(const LAS f32x4*)(SC + 64 + 32 + 8 * g + 4 * hh);
#pragma unroll
                for (int e = 0; e < 4; ++e) { acc0[4 * g + e] *= w0[e]; acc1[4 * g + e] *= w1[e]; } }
              acc0 = ML_MFMA(x00, vf[0], acc0); acc1 = ML_MFMA(x20, vf[2], acc1); acc0 = ML_MFMA(x01, vf[1], acc0); acc1 = ML_MFMA(x21, vf[3], acc1);
              if (dir == 0) { acc1 = ML_MFMA(x10, vf[0], acc1); acc1 = ML_MFMA(x11, vf[1], acc1); }
              else          { acc0 = ML_MFMA(x10, vf[2], acc0); acc0 = ML_MFMA(x11, vf[3], acc0); } }
            { ML_FRESH(); float* hp = HF + (rowbase + 64 * cn) * 512 + h * 128 + 32 * w + r32;
#pragma unroll
              for (int g = 0; g < 4; ++g) { const f32x4 r0 = *(const LAS f32x4*)(VEC + V_RD + 64 * w + 8 * g + 4 * hh), r1 = *(const LAS f32x4*)(VEC + V_RD + 64 * w + 32 + 8 * g + 4 * hh);
#pragma unroll
                  for (int e = 0; e < 4; ++e) { const int t = 8 * g + 4 * hh + e; hp[(size_t)t * 512] = acc0[4 * g + e] * r0[e]; hp[(size_t)(32 + t) * 512] = acc1[4 * g + e] * r1[e]; } } }
            { ML_FRESH(); const int blk = (ln >> 4) & 1, q = (ln & 15) >> 2, p = ln & 3;
              const LAS unsigned char* kb0 = Kb + 256 * (4 * hh + q) + 8 * (p & 1); const unsigned c0 = 2 * blk + (p >> 1), f0 = ((unsigned)q << 2) | (unsigned)hh, f1 = ((unsigned)q << 2) | (unsigned)(2 + hh);
              s16x4 kl[2], kh[2];
#define ML_KLD(gi, buf) do { const int db_ = (gi) >> 2, ks_ = (gi) & 3; kl[buf] = __builtin_bit_cast(s16x4, __builtin_amdgcn_ds_read_tr16_b64_v4i16((LAS v4i16_t*)(kb0 + 256 * (16 * ks_) + 16 * ((4 * db_ + c0) ^ f0)))); \
                               kh[buf] = __builtin_bit_cast(s16x4, __builtin_amdgcn_ds_read_tr16_b64_v4i16((LAS v4i16_t*)(kb0 + 256 * (16 * ks_ + 8) + 16 * ((4 * db_ + c0) ^ f1)))); } while (0)
              ML_KLD(0, 0);
#pragma unroll
              for (int gi = 0; gi < 16; ++gi) {
                  if (gi + 1 < 16) ML_KLD(gi + 1, (gi + 1) & 1);
                  if ((gi & 3) == 0) {
#pragma unroll
                      for (int r = 0; r < 16; ++r) CT[gi >> 2][r] *= decay; }
                  const bf16x8 kt = {kl[gi & 1][0], kl[gi & 1][1], kl[gi & 1][2], kl[gi & 1][3], kh[gi & 1][0], kh[gi & 1][1], kh[gi & 1][2], kh[gi & 1][3]};
                  CT[gi >> 2] = ML_MFMA(kt, vf[gi & 3], CT[gi >> 2]); ML_SB(); }
#undef ML_KLD
            }
            ML_BAR();
        }
#undef ML_VLOAD
#undef ML_SB
    }
#undef ML_FRESH
#undef ML_CHUNK
#undef ML_BAR
}
}
__device__ __forceinline__ void attn_naive_item(const bf16* Q, const bf16* K, const bf16* V, bf16* Y, int item, int tid) {
    const int b = item >> 6, h = (item >> 3) & 7, seg = item & 7, kvh = h >> 2;
    const size_t row = (size_t)b * SEQ + seg * 512 + tid;
    float q[64], o[64];
    { const v4u* qp = (const v4u*)(Q + row * 512 + h * 64);
#pragma unroll
      for (int i = 0; i < 8; ++i) { const v4u w = qp[i]; q[8 * i] = bflo(w.x); q[8 * i + 1] = bfhi(w.x); q[8 * i + 2] = bflo(w.y); q[8 * i + 3] = bfhi(w.y); q[8 * i + 4] = bflo(w.z); q[8 * i + 5] = bfhi(w.z); q[8 * i + 6] = bflo(w.w); q[8 * i + 7] = bfhi(w.w); } }
#pragma unroll
    for (int d = 0; d < 64; ++d) o[d] = 0.f;
    float m = -1e30f, l = 0.f;
    int z = 0; asm volatile("" : "+v"(z));
    const bf16* Kp = K + (size_t)b * SEQ * 128 + kvh * 64 + z; const bf16* Vp = V + (size_t)b * SEQ * 128 + kvh * 64 + z;
    for (int s = 0; s < SEQ; ++s) {
        const v4u* kr = (const v4u*)(Kp + (size_t)s * 128); float dot = 0.f;
#pragma unroll
        for (int i = 0; i < 8; ++i) { const v4u w = kr[i]; dot += q[8 * i] * bflo(w.x) + q[8 * i + 1] * bfhi(w.x) + q[8 * i + 2] * bflo(w.y) + q[8 * i + 3] * bfhi(w.y) + q[8 * i + 4] * bflo(w.z) + q[8 * i + 5] * bfhi(w.z) + q[8 * i + 6] * bflo(w.w) + q[8 * i + 7] * bfhi(w.w); }
        const float mn = fmaxf(m, dot), corr = exp2f(m - mn), p = exp2f(dot - mn); l = l * corr + p; m = mn;
        const v4u* vr = (const v4u*)(Vp + (size_t)s * 128);
#pragma unroll
        for (int i = 0; i < 8; ++i) { const v4u w = vr[i];
            o[8 * i] = o[8 * i] * corr + p * bflo(w.x); o[8 * i + 1] = o[8 * i + 1] * corr + p * bfhi(w.x); o[8 * i + 2] = o[8 * i + 2] * corr + p * bflo(w.y); o[8 * i + 3] = o[8 * i + 3] * corr + p * bfhi(w.y);
            o[8 * i + 4] = o[8 * i + 4] * corr + p * bflo(w.z); o[8 * i + 5] = o[8 * i + 5] * corr + p * bfhi(w.z); o[8 * i + 6] = o[8 * i + 6] * corr + p * bflo(w.w); o[8 * i + 7] = o[8 * i + 7] * corr + p * bfhi(w.w); }
    }
    const float inv = 1.0f / l; v4u* yp = (v4u*)(Y + row * 1024 + h * 64);
#pragma unroll
    for (int i = 0; i < 8; ++i) { v4u w; w.x = pk2(o[8 * i] * inv, o[8 * i + 1] * inv); w.y = pk2(o[8 * i + 2] * inv, o[8 * i + 3] * inv); w.z = pk2(o[8 * i + 4] * inv, o[8 * i + 5] * inv); w.w = pk2(o[8 * i + 6] * inv, o[8 * i + 7] * inv); yp[i] = w; }
}
__device__ __forceinline__ void mlstm_naive_item(const Args& A, int item, LAS float* lds, int tid) {
    const int b = item >> 3, h = (item >> 1) & 3, dir = item & 1, v = tid >> 2, dq = tid & 3;
    const bf16* QKM = (const bf16*)(A.ws + WS_QKM); const bf16* VM = (const bf16*)(A.ws + WS_VM); const float* GT = (const float*)(A.ws + WS_GATES);
    float* HF = (float*)(A.ws + WS_HF) + (size_t)dir * M * 512; const float* cw = A.in[I_CONVW]; const float* cb = A.in[I_CONVB];
    LAS float* qs = lds; LAS float* ks = lds + 32 * 128; LAS float* vs = lds + 2 * 32 * 128; LAS float* gi = lds + 3 * 32 * 128; LAS float* gf = gi + 32;
    float C[32], n[32]; float m = 0.f;
#pragma unroll
    for (int i = 0; i < 32; ++i) { C[i] = 0.f; n[i] = 0.f; }
    for (int blk = 0; blk < SEQ / 32; ++blk) {
        for (int idx = tid; idx < 32 * 256; idx += NTHREADS) { const int tt = idx >> 8, c = idx & 255, p = blk * 32 + tt, pos = dir ? SEQ - 1 - p : p;
            const int ch = (c < 128) ? h * 128 + c : 512 + h * 128 + (c - 128); float a = cb[ch];
#pragma unroll
            for (int j = 0; j < 5; ++j) { const int pp = pos - 2 + j; if (pp >= 0 && pp < SEQ) a += cw[j * 1024 + ch] * bf2f(QKM[((size_t)b * SEQ + pp) * 1024 + ch]); }
            const float sv = a / (1.0f + expf(-a));
            if (c < 128) qs[tt * 128 + c] = sv; else ks[tt * 128 + c - 128] = sv * 0.08838834764831845f; }
        for (int idx = tid; idx < 32 * 128; idx += NTHREADS) { const int tt = idx >> 7, c = idx & 127, p = blk * 32 + tt, pos = dir ? SEQ - 1 - p : p; vs[tt * 128 + c] = bf2f(VM[((size_t)b * SEQ + pos) * 512 + h * 128 + c]); }
        if (tid < 32) { const int p = blk * 32 + tid, pos = dir ? SEQ - 1 - p : p; const float* gp = GT + ((size_t)b * SEQ + pos) * 16; gi[tid] = gp[dir * 8 + h]; const float f = gp[dir * 8 + 4 + h]; gf[tid] = fminf(f, 0.f) - log1pf(expf(-fabsf(f))); }
        __syncthreads();
        for (int tt = 0; tt < 32; ++tt) {
            const float it = gi[tt], lf = gf[tt], mn = fmaxf(lf + m, it), fg = expf(lf + m - mn), ig = expf(it - mn); m = mn;
            const float vv = vs[tt * 128 + v] * ig; float num = 0.f, den = 0.f;
#pragma unroll
            for (int i4 = 0; i4 < 8; ++i4) { const f32x4 kd = *(const LAS f32x4*)(ks + tt * 128 + dq * 32 + 4 * i4), qd = *(const LAS f32x4*)(qs + tt * 128 + dq * 32 + 4 * i4);
#pragma unroll
                for (int e = 0; e < 4; ++e) { const int i = 4 * i4 + e; C[i] = fg * C[i] + vv * kd[e]; n[i] = fg * n[i] + ig * kd[e]; num += C[i] * qd[e]; den += n[i] * qd[e]; } }
            num += __shfl_xor(num, 1); num += __shfl_xor(num, 2); den += __shfl_xor(den, 1); den += __shfl_xor(den, 2);
            if (dq == 0) { const int p = blk * 32 + tt, pos = dir ? SEQ - 1 - p : p; HF[((size_t)b * SEQ + pos) * 512 + h * 128 + v] = num / fmaxf(fabsf(den), expf(-mn)); }
        }
        __syncthreads();
    }
}
__device__ __forceinline__ void finalize_pass(const Args& A, int lane, int gw, int NGW) {
    const float* H0 = (const float*)(A.ws + WS_HF); const float* H1 = H0 + (size_t)M * 512; const bf16* OM = (const bf16*)(A.ws + WS_OM); bf16* Y = (bf16*)(A.ws + WS_Y);
    const f32x4 g0 = *(const f32x4*)(A.in[I_MNG] + 8 * lane), g1 = *(const f32x4*)(A.in[I_MNG] + 8 * lane + 4);
    for (int row = gw; row < M; row += NGW) {
        const f32x4 a0 = *(const f32x4*)(H0 + (size_t)row * 512 + 8 * lane), a1 = *(const f32x4*)(H0 + (size_t)row * 512 + 8 * lane + 4);
        const f32x4 b0 = *(const f32x4*)(H1 + (size_t)row * 512 + 8 * lane), b1 = *(const f32x4*)(H1 + (size_t)row * 512 + 8 * lane + 4);
        const f32x4 h0 = a0 + b0, h1 = a1 + b1;
        float ss = (h0[0] * h0[0] + h0[1] * h0[1]) + (h0[2] * h0[2] + h0[3] * h0[3]) + (h1[0] * h1[0] + h1[1] * h1[1]) + (h1[2] * h1[2] + h1[3] * h1[3]);
        ss += __shfl_xor(ss, 1); ss += __shfl_xor(ss, 2); ss += __shfl_xor(ss, 4); ss += __shfl_xor(ss, 8);
        const float rstd = 1.0f / sqrtf(ss * (1.0f / 128.0f) + EPS);
        const v4u ow = *(const v4u*)(OM + (size_t)row * 512 + 8 * lane);
        const float og[8] = {bflo(ow.x), bfhi(ow.x), bflo(ow.y), bfhi(ow.y), bflo(ow.z), bfhi(ow.z), bflo(ow.w), bfhi(ow.w)};
        float y[8];
#pragma unroll
        for (int e = 0; e < 4; ++e) { y[e] = h0[e] * rstd * g0[e] / (1.0f + expf(-og[e])); y[4 + e] = h1[e] * rstd * g1[e] / (1.0f + expf(-og[4 + e])); }
        v4u w; w.x = pk2(y[0], y[1]); w.y = pk2(y[2], y[3]); w.z = pk2(y[4], y[5]); w.w = pk2(y[6], y[7]);
        *(v4u*)(Y + (size_t)row * 1024 + 512 + 8 * lane) = w;
    }
}

__global__ void __launch_bounds__(NTHREADS, 2) hymba_fwd(Args args) {
    extern __shared__ __attribute__((aligned(16))) unsigned char lds_raw[];
    LAS unsigned char* lds = (LAS unsigned char*)lds_raw;
    volatile LAS unsigned* MISC = (volatile LAS unsigned*)(lds + MISC_OFF);
    const int tid = threadIdx.x, lane = tid & 63, wave = __builtin_amdgcn_readfirstlane(tid >> 6);
    const int G = gridDim.x, bx = blockIdx.x, vcu = (G % 8 == 0) ? (bx % 8) * (G / 8) + bx / 8 : bx;
    const int gw = vcu * NWAVES + wave, NGW = G * NWAVES;
    unsigned char* ws = args.ws; gu32* ctl = (gu32*)(ws + WS_CTL);
    for (int u = tid; u < (LDS_BYTES - LDSCTL_OFF) / 4; u += NTHREADS) ((LAS unsigned*)(lds + LDSCTL_OFF))[u] = 0u;
    __syncthreads();
    XcdBarrier bar; bar.bar = (unsigned*)(ctl + CW_BAR); bar.x = 0; bar.st = nullptr;
    if (N_LAUNCHES == 1) bar = xcd_barrier_post((unsigned*)(ctl + CW_BAR), MISC + 8);
#define GRID_BAR() do { if (N_LAUNCHES == 1) xcd_barrier(bar); } while (0)
    const int lo = args.ph_lo, hi = args.ph_hi;
#define IN(k) (lo <= (k) && (k) < hi)
#define BOTH(k) (IN(k) && IN((k) + 1))
#define REP(k) ((DUP_PHASE == (k) || ((k) == 4 && (DUP_PHASE == 41 || DUP_PHASE == 42))) ? 2 : 1)
#define PHASE(k) if (IN(k)) for (int rep = 0; rep < REP(k); ++rep)
#define ENDBAR(k) do { if (BOTH(k) || rep + 1 < REP(k)) GRID_BAR(); } while (0)
    bf16* XN = (bf16*)(ws + WS_XN); float* mod = (float*)(ws + WS_MOD);

    PHASE(0) { p0_prologue(args, lds, tid, lane, wave, vcu, G); ENDBAR(0); }
    PHASE(1) { row_pass<0>(args, lane, gw, NGW); ENDBAR(1); }
    PHASE(2) {
        gates_pass(args, lane, gw, NGW);
        pg8::Gemm g{XN, (const bf16*)(ws + WS_WIN), M, NPROJ, DMODEL}; pg8::StaticOrder S; S.init(M, NPROJ, G, bx);
        pg8::EpiInProj E{ws};
#if NAIVE_GEMM
        pg8::gemm_simple<pg8::EpiInProj, pg8::StaticOrder>(g, S, E);
#else
        pg8::gemm_phase<pg8::EpiInProj, pg8::StaticOrder, PG8_ALIGN, PG8_SP2>(lds, g, S, E);
#endif
        ENDBAR(2);
    }
    PHASE(3) { ml::prep_pass(args, lds, tid, bx, G); ENDBAR(3); }
    PHASE(4) {
#if NAIVE_MLSTM
        for (int it = bx; it < 64; it += G) mlstm_naive_item(args, it, (LAS float*)lds, tid);
#else
        if (!(DUP_PHASE == 42 && rep == 1)) for (int it = bx; it < 64; it += G) ml::mlstm_item(args, it, lds, tid);
#endif
#if NAIVE_ATTN
        for (int it = bx; it < 512; it += G) attn_naive_item((const bf16*)(ws + WS_Q), (const bf16*)(ws + WS_K), (const bf16*)(ws + WS_V), (bf16*)(ws + WS_Y), it, tid);
#else
        { const attn_body::AttnTensors AT{(const attn_body::bf16*)(ws + WS_Q), (const attn_body::bf16*)(ws + WS_K), (const attn_body::bf16*)(ws + WS_V), (attn_body::bf16*)(ws + WS_Y)};
          const attn_body::QueueOrder S{(unsigned*)(ctl + CW_QUEUE + 64 * rep), (volatile LAS unsigned*)(MISC + 16)}; if (!(DUP_PHASE == 41 && rep == 1)) attn_body::attn_phase<attn_body::QueueOrder>((char*)lds_raw, AT, S); }
#endif
        ENDBAR(4);
    }
    PHASE(5) { finalize_pass(args, lane, gw, NGW); ENDBAR(5); }
    PHASE(6) {
        pg8::Gemm g{(const bf16*)(ws + WS_Y), (const bf16*)(ws + WS_WO), M, DMODEL, DMODEL}; pg8::StaticOrder S; S.init(M, DMODEL, G, bx);
        pg8::EpiResGate E{args.in[I_X], args.out, mod + 2048};
#if NAIVE_GEMM
        pg8::gemm_simple<pg8::EpiResGate, pg8::StaticOrder>(g, S, E);
#else
        pg8::gemm_phase<pg8::EpiResGate, pg8::StaticOrder, PG8_ALIGN, PG8_SP2>(lds, g, S, E);
#endif
        ENDBAR(6);
    }
    PHASE(7) { row_pass<1>(args, lane, gw, NGW); ENDBAR(7); }
    PHASE(8) {
        pg8::Gemm g{XN, (const bf16*)(ws + WS_WGU), M, 2 * FFH, DMODEL}; pg8::StaticOrder S; S.init(M, 2 * FFH, G, bx);
        pg8::EpiSwiGLU E{(bf16*)(ws + WS_ACT)};
#if NAIVE_GEMM
        pg8::gemm_simple<pg8::EpiSwiGLU, pg8::StaticOrder>(g, S, E);
#else
        pg8::gemm_phase<pg8::EpiSwiGLU, pg8::StaticOrder, PG8_ALIGN, PG8_SP2>(lds, g, S, E);
#endif
        ENDBAR(8);
    }
    PHASE(9) {
        pg8::Gemm g{(const bf16*)(ws + WS_ACT), (const bf16*)(ws + WS_WD), M, DMODEL, FFH}; pg8::StaticOrder S; S.init(M, DMODEL, G, bx);
        pg8::EpiResGate E{args.out, args.out, mod + 5120};
#if NAIVE_GEMM
        pg8::gemm_simple<pg8::EpiResGate, pg8::StaticOrder>(g, S, E);
#else
        pg8::gemm_phase<pg8::EpiResGate, pg8::StaticOrder, PG8_ALIGN, PG8_SP2>(lds, g, S, E);
#endif
        ENDBAR(9);
    }
    PHASE(10) { row_pass<2>(args, lane, gw, NGW); }
#undef IN
#undef REP
#undef PHASE
#undef ENDBAR
#undef BOTH
}

extern "C" void kernel_launch(void* const* d_in, const int* in_sizes, int n_in, void* d_out, int out_size, void* d_ws, size_t ws_size, hipStream_t stream) {
    static int grid = 0;
    if (grid == 0) {
        if (n_in != 18 || in_sizes[0] != M * DMODEL || out_size != M * DMODEL || ws_size < WS_END) { fprintf(stderr, "kernel_launch: unexpected shapes (n_in %d, in0 %d, out %d, ws %zu < %zu)\n", n_in, n_in > 0 ? in_sizes[0] : -1, out_size, ws_size, (size_t)WS_END); grid = -1; return; }
        int dev = 0, cus = 0, per_cu = 0;
        if (hipGetDevice(&dev) != hipSuccess || hipDeviceGetAttribute(&cus, hipDeviceAttributeMultiprocessorCount, dev) != hipSuccess) { grid = -1; return; }
        if (hipFuncSetAttribute((const void*)hymba_fwd, hipFuncAttributeMaxDynamicSharedMemorySize, LDS_BYTES) != hipSuccess) { fprintf(stderr, "kernel_launch: hipFuncSetAttribute failed\n"); grid = -1; return; }
        if (hipOccupancyMaxActiveBlocksPerMultiprocessor(&per_cu, (const void*)hymba_fwd, NTHREADS, LDS_BYTES) != hipSuccess || per_cu < 1) { fprintf(stderr, "kernel_launch: occupancy query says %d blocks per CU\n", per_cu); (void)hipGetLastError(); grid = -1; return; }
        grid = cus;
    }
    if (grid < 0) return;
    if (hipMemsetAsync((char*)d_ws + WS_CTL, 0, CTL_ZERO_BYTES, stream) != hipSuccess) return;
    Args a{};
    for (int i = 0; i < 18; ++i) a.in[i] = (const float*)d_in[i];
    a.out = (float*)d_out; a.ws = (unsigned char*)d_ws;
    if (N_LAUNCHES == 1) { a.ph_lo = 0; a.ph_hi = NPHASE; hipLaunchKernelGGL(hymba_fwd, dim3(grid), dim3(NTHREADS), LDS_BYTES, stream, a); }
    else for (int p = 0; p < NPHASE; ++p) { a.ph_lo = p; a.ph_hi = p + 1; hipLaunchKernelGGL(hymba_fwd, dim3(grid), dim3(NTHREADS), LDS_BYTES, stream, a); }
}
```
